# Optimizing an MI355X kernel written in HIP

```python
import jax, jax.numpy as jnp
from jax import lax
import numpy as np

D_MODEL = 4096
BATCH = 2
SEQ = 8192
DEPTH = 2

N_BRANCH = 4
BRANCH_WIDTH = D_MODEL // 4
HEAD_DIM = 128
MOBA_HEADS = BRANCH_WIDTH // HEAD_DIM
MOBA_BLOCK = 256
MOBA_TOPK = 3
MOBA_Q_CHUNK = 32
FOX_HEADS = BRANCH_WIDTH // HEAD_DIM
FOX_Q_BLOCK = 128
POOL_WINDOWS = (2, 4, 8, 16)
POOL_GROUPS = len(POOL_WINDOWS)
POOL_GROUP_WIDTH = BRANCH_WIDTH // POOL_GROUPS
CONV_K = 3
RMS_EPS = 1e-6
NEG_INF = -1e30

_W = BRANCH_WIDTH
_IN_SEGMENTS = (3 * _W, _W,
                3 * _W, _W, FOX_HEADS,
                _W, _W,
                3 * _W, _W,
                N_BRANCH * D_MODEL)
IN_SPLITS = tuple(int(v) for v in np.cumsum(_IN_SEGMENTS)[:-1])
N_IN = int(sum(_IN_SEGMENTS))

kernel_name = "hybrid_moba_fox_pool_conv_gated_merge"


def rms_norm(x, g):
    x32 = x.astype(jnp.float32)
    y = x32 * lax.rsqrt(jnp.mean(x32 * x32, axis=-1, keepdims=True) + RMS_EPS)
    return (y * g.astype(jnp.float32)).astype(x.dtype)


def split_heads(t, n_heads):
    b, s, _ = t.shape
    return t.reshape(b, s, n_heads, HEAD_DIM).transpose(0, 2, 1, 3)


def merge_heads(t):
    b, h, s, d = t.shape
    return t.transpose(0, 2, 1, 3).reshape(b, s, h * d)


def moba_attention(q, k, v):
    b, h, s, d = q.shape
    nb = -(-s // MOBA_BLOCK)
    s_pad = nb * MOBA_BLOCK
    pad = ((0, 0), (0, 0), (0, s_pad - s), (0, 0))
    kb = jnp.pad(k, pad).reshape(b, h, nb, MOBA_BLOCK, d)
    vb = jnp.pad(v, pad).reshape(b, h, nb, MOBA_BLOCK, d)
    scale = HEAD_DIM ** -0.5
    k_mean = jnp.mean(kb.astype(jnp.float32), axis=3)
    gate = jnp.einsum("bhsd,bhnd->bhsn", q.astype(jnp.float32), k_mean)
    q_blk = jnp.arange(s) // MOBA_BLOCK
    past = jnp.arange(nb)[None, :] < q_blk[:, None]
    gate = jnp.where(past, gate, NEG_INF)
    topk = min(MOBA_TOPK, nb)
    _, idx = lax.top_k(gate, topk)
    valid = idx < q_blk[None, None, :, None]

    nc = s // MOBA_Q_CHUNK

    def to_chunks(t):
        t = t.reshape((b, h, nc, MOBA_Q_CHUNK) + t.shape[3:])
        return jnp.moveaxis(t, 2, 0)

    gather = jax.vmap(jax.vmap(lambda blocks, i: blocks[i]))

    def chunk(args):
        qc, ic, vc, c = args
        t_pos = c * MOBA_Q_CHUNK + jnp.arange(MOBA_Q_CHUNK)
        blk = (c * MOBA_Q_CHUNK) // MOBA_BLOCK
        k_sel = gather(kb, ic).reshape(b, h, MOBA_Q_CHUNK, topk * MOBA_BLOCK, d)
        v_sel = gather(vb, ic).reshape(b, h, MOBA_Q_CHUNK, topk * MOBA_BLOCK, d)
        s_sel = jnp.einsum("bhqd,bhqkd->bhqk", qc, k_sel).astype(jnp.float32) * scale
        s_sel = jnp.where(jnp.repeat(vc, MOBA_BLOCK, axis=-1), s_sel, NEG_INF)
        k_own = lax.dynamic_index_in_dim(kb, blk, axis=2, keepdims=False)
        v_own = lax.dynamic_index_in_dim(vb, blk, axis=2, keepdims=False)
        s_own = jnp.einsum("bhqd,bhkd->bhqk", qc, k_own).astype(jnp.float32) * scale
        own_pos = blk * MOBA_BLOCK + jnp.arange(MOBA_BLOCK)
        s_own = jnp.where(own_pos[None, :] <= t_pos[:, None], s_own, NEG_INF)
        p = jax.nn.softmax(jnp.concatenate([s_sel, s_own], axis=-1), axis=-1).astype(v.dtype)
        n_sel = topk * MOBA_BLOCK
        return (jnp.einsum("bhqk,bhqkd->bhqd", p[..., :n_sel], v_sel)
                + jnp.einsum("bhqk,bhkd->bhqd", p[..., n_sel:], v_own))

    out = lax.map(chunk, (to_chunks(q), to_chunks(idx), to_chunks(valid), jnp.arange(nc)))
    return jnp.moveaxis(out, 0, 2).reshape(b, h, s, d)


def fox_attention(q, k, v, log_f):
    b, h, s, d = q.shape
    scale = HEAD_DIM ** -0.5
    c = jnp.cumsum(log_f, axis=-1)
    nq = s // FOX_Q_BLOCK
    k_pos = jnp.arange(s)
    q_blocks = jnp.moveaxis(q.reshape(b, h, nq, FOX_Q_BLOCK, d), 2, 0)
    c_blocks = jnp.moveaxis(c.reshape(b, h, nq, FOX_Q_BLOCK), 2, 0)

    def block(args):
        qb, cb, i = args
        t_pos = i * FOX_Q_BLOCK + jnp.arange(FOX_Q_BLOCK)
        logits = (jnp.einsum("bhqd,bhkd->bhqk", qb, k).astype(jnp.float32) * scale
                  + cb[..., None] - c[:, :, None, :])
        logits = jnp.where(k_pos[None, :] <= t_pos[:, None], logits, NEG_INF)
        p = jax.nn.softmax(logits, axis=-1).astype(v.dtype)
        return jnp.einsum("bhqk,bhkd->bhqd", p, v)

    out = lax.map(block, (q_blocks, c_blocks, jnp.arange(nq)))
    return jnp.moveaxis(out, 0, 2).reshape(b, h, s, d)


def pool_mixer(u, w_pool, pool_scale):
    b, s, w_total = u.shape
    u32 = u.astype(jnp.float32)
    csum = jnp.concatenate([jnp.zeros((b, 1, w_total), jnp.float32), jnp.cumsum(u32, axis=1)], axis=1)
    t = jnp.arange(s)
    outs = []
    for g, win in enumerate(POOL_WINDOWS):
        sl = slice(g * POOL_GROUP_WIDTH, (g + 1) * POOL_GROUP_WIDTH)
        cg = csum[..., sl]
        lag = jnp.concatenate([jnp.zeros((b, win - 1, POOL_GROUP_WIDTH), jnp.float32),
                               cg[:, :s + 1 - win]], axis=1)
        cnt = jnp.minimum(t + 1, win).astype(jnp.float32)[None, :, None]
        outs.append((cg[:, 1:] - lag) / cnt - u32[..., sl])
    pooled = jnp.stack(outs, axis=2).astype(u.dtype)
    y = jnp.einsum("bsgc,gcd->bsgd", pooled, w_pool).reshape(b, s, w_total)
    return y * pool_scale


def short_conv_mixer(bcx, w_conv):
    b_g, c_g, xs = jnp.split(bcx, 3, axis=-1)
    z = c_g * xs
    width = z.shape[-1]
    y = lax.conv_general_dilated(z, w_conv[:, None, :].astype(z.dtype), window_strides=(1,),
                                 padding=[(CONV_K - 1, 0)],
                                 dimension_numbers=("NWC", "WIO", "NWC"),
                                 feature_group_count=width)
    return b_g * y


def hybrid_layer(x, g_norm, w_in, b_forget, w_pool, pool_scale, w_conv, w_branch, b_merge, w_out):
    b, s, d = x.shape
    hn = rms_norm(x, g_norm)
    proj = jnp.einsum("bsd,dn->bsn", hn, w_in)
    (a_qkv, a_gate, f_qkv, f_gate, f_forget, p_in, p_gate, c_bcx, c_gate,
     m_gate) = jnp.split(proj, IN_SPLITS, axis=-1)
    qa, ka, va = [split_heads(t, MOBA_HEADS) for t in jnp.split(a_qkv, 3, axis=-1)]
    o_a = merge_heads(moba_attention(qa, ka, va))
    qf, kf, vf = [split_heads(t, FOX_HEADS) for t in jnp.split(f_qkv, 3, axis=-1)]
    log_f = jax.nn.log_sigmoid((f_forget + b_forget).astype(jnp.float32)).transpose(0, 2, 1)
    o_b = merge_heads(fox_attention(qf, kf, vf, log_f))
    o_c = pool_mixer(p_in, w_pool, pool_scale)
    o_d = short_conv_mixer(c_bcx, w_conv)
    branches = (o_a * jax.nn.silu(a_gate), o_b * jax.nn.silu(f_gate),
                o_c * jax.nn.silu(p_gate), o_d * jax.nn.silu(c_gate))
    m_gate = m_gate.reshape(b, s, N_BRANCH, d) + b_merge
    merged = jnp.zeros_like(x)
    for i in range(N_BRANCH):
        up = jnp.einsum("bsw,wd->bsd", branches[i], w_branch[i])
        merged = merged + jax.nn.sigmoid(m_gate[:, :, i]) * up
    return x + jnp.einsum("bsd,de->bse", merged, w_out)


def setup_inputs(seed: int = 0) -> dict:
    key = jax.random.key(seed)
    ks = jax.random.split(key, 12)
    f32 = jnp.float32
    x = jax.random.normal(ks[0], (BATCH, SEQ, D_MODEL), f32)
    norm_g = 1.0 + 0.02 * jax.random.normal(ks[1], (DEPTH, D_MODEL), f32)
    w_in = jax.random.normal(ks[2], (DEPTH, D_MODEL, N_IN), f32) * D_MODEL ** -0.5
    b_forget = jax.random.uniform(ks[3], (DEPTH, FOX_HEADS), f32, minval=1.0, maxval=6.0)
    w_pool = jax.random.normal(ks[4], (DEPTH, POOL_GROUPS, POOL_GROUP_WIDTH, POOL_GROUP_WIDTH), f32) * POOL_GROUP_WIDTH ** -0.5
    pool_scale = 1.0 + 0.02 * jax.random.normal(ks[5], (DEPTH, BRANCH_WIDTH), f32)
    w_conv = jax.random.normal(ks[6], (DEPTH, CONV_K, BRANCH_WIDTH), f32) * CONV_K ** -0.5
    w_branch = jax.random.normal(ks[7], (DEPTH, N_BRANCH, BRANCH_WIDTH, D_MODEL), f32) * BRANCH_WIDTH ** -0.5
    b_merge = 0.02 * jax.random.normal(ks[8], (DEPTH, N_BRANCH, D_MODEL), f32)
    w_out = jax.random.normal(ks[9], (DEPTH, D_MODEL, D_MODEL), f32) * D_MODEL ** -0.5
    final_g = 1.0 + 0.02 * jax.random.normal(ks[10], (D_MODEL,), f32)
    return {"x": x, "norm_g": norm_g, "w_in": w_in, "b_forget": b_forget, "w_pool": w_pool,
            "pool_scale": pool_scale, "w_conv": w_conv, "w_branch": w_branch,
            "b_merge": b_merge, "w_out": w_out, "final_g": final_g}


def reference(x, norm_g, w_in, b_forget, w_pool, pool_scale, w_conv, w_branch, b_merge, w_out, final_g):
    h = x
    for layer in range(DEPTH):
        h = hybrid_layer(h, norm_g[layer], w_in[layer], b_forget[layer], w_pool[layer],
                         pool_scale[layer], w_conv[layer], w_branch[layer], b_merge[layer],
                         w_out[layer])
    return rms_norm(h, final_g)
```

```cpp
#include <hip/hip_runtime.h>
#include <cstdio>
#include <cstdint>

namespace pg8 {
#define PG8_LAS __attribute__((address_space(3)))
typedef unsigned short bf16_t;
typedef short bf16x8 __attribute__((ext_vector_type(8)));
typedef float f32x4 __attribute__((ext_vector_type(4)));
typedef unsigned u32x4 __attribute__((ext_vector_type(4)));
constexpr int BM = 256, BK = 64, HALF = 128, HTB = HALF * BK * 2  , STAGE_BYTES = 8 * HTB, NXCD = 8, WGM = 8;

__host__ __device__ __forceinline__ int lds_byte(int r, int c) { const int st = (r >> 4) * 2 + (c >> 5), rr = r & 15, cc = c & 31, ob = rr * 64 + cc * 2; return st * 1024 + (ob ^ (((ob >> 9) & 1) << 5)); }
__host__ __device__ __forceinline__ void stage_rc(int b, int& R, int& C) { const int st = b / 1024, sb = b % 1024, swz = sb ^ (((sb >> 9) & 1) << 5); R = (st >> 1) * 16 + swz / 64; C = (st & 1) * 32 + (swz % 64) / 2; }
__host__ __device__ __forceinline__ int perm32(int rho) { const int n = rho >> 4, i = rho & 15; return 8 * (i >> 2) + 4 * n + (i & 3); }

struct Unit { int pm, pn, z; };

struct StaticOrder {
    int nM, nN, nwg, G, c;
    __host__ __device__ void init(int M, int N, int G_, int c_) { nM = M / BM; nN = N / BM; nwg = nM * nN; G = G_; c = c_; }
    __host__ __device__ bool next(int i, Unit& u) const {
        const long L = (long)i * G + c; if (L >= nwg) return false;
        int wgid = (int)L; { const int q = nwg / NXCD, r = nwg % NXCD, xcd = wgid % NXCD, off = wgid / NXCD; wgid = (xcd < r ? xcd * (q + 1) : r * (q + 1) + (xcd - r) * q) + off; }
        const int nig = WGM * nN, gid = wgid / nig, fm = gid * WGM, gsz = (nM - fm) < WGM ? (nM - fm) : WGM;
        u.pm = fm + ((wgid % nig) % gsz); u.pn = (wgid % nig) / gsz; u.z = 0; return true;
    }
    __device__ __forceinline__ void a_ready(const Unit&) const {}
    __device__ __forceinline__ void done(const Unit&) const {}
};
struct QuadOrder {
    StaticOrder base;
    __host__ __device__ bool next(int i, Unit& u) const { if (!base.next(i >> 2, u)) return false; u.z = i & 3; return true; }
    __device__ __forceinline__ void a_ready(const Unit&) const {}
    __device__ __forceinline__ void done(const Unit&) const {}
};

__device__ __forceinline__ unsigned cvt_pk_bf16(float lo, float hi) { unsigned r; asm volatile("v_cvt_pk_bf16_f32 %0, %1, %2" : "=v"(r) : "v"(lo), "v"(hi)); return r; }
__device__ __forceinline__ float bf_lo(unsigned w) { return __uint_as_float(w << 16); }
__device__ __forceinline__ float bf_hi(unsigned w) { return __uint_as_float(w & 0xffff0000u); }
__device__ __forceinline__ float sigmoidf_fast(float x) { return __builtin_amdgcn_rcpf(1.0f + __builtin_amdgcn_exp2f(-1.4426950408889634f * x)); }

struct EpiStoreBf16 {
    static constexpr bool PERM = true, AFTER_DRAIN = false;
    bf16_t* O; int ldc;
    __device__ __forceinline__ void operator()(const f32x4 (&acc)[2][2][4][2], const Unit& u, int wr, int wc, int fr, int fq) const {
        const int row0 = u.pm * BM + wr * 64 + fr, col0 = u.pn * BM + wc * 32 + 8 * fq;
#pragma unroll
        for (int ai = 0; ai < 2; ++ai)
#pragma unroll
            for (int m = 0; m < 4; ++m) { bf16_t* rowp = O + (size_t)(row0 + ai * HALF + m * 16) * ldc + col0;
#pragma unroll
                for (int bj = 0; bj < 2; ++bj) { const f32x4 v0 = acc[ai][bj][m][0], v1 = acc[ai][bj][m][1];
                    u32x4 w; w.x = cvt_pk_bf16(v0[0], v0[1]); w.y = cvt_pk_bf16(v0[2], v0[3]); w.z = cvt_pk_bf16(v1[0], v1[1]); w.w = cvt_pk_bf16(v1[2], v1[3]);
                    *(u32x4*)(rowp + bj * HALF) = w; } }
    }
};
struct EpiPool {
    static constexpr bool PERM = true, AFTER_DRAIN = false;
    bf16_t* O; int ldc; const float* pscale; const bf16_t* gate; int ldg;
    __device__ __forceinline__ void operator()(const f32x4 (&acc)[2][2][4][2], const Unit& u, int wr, int wc, int fr, int fq) const {
        const int row0 = u.pm * BM + wr * 64 + fr, col0 = u.pn * BM + wc * 32 + 8 * fq;
        f32x4 ps[2][2];
#pragma unroll
        for (int bj = 0; bj < 2; ++bj)
#pragma unroll
            for (int n = 0; n < 2; ++n) ps[bj][n] = *(const f32x4*)(pscale + col0 + bj * HALF + 4 * n);
#pragma unroll
        for (int ai = 0; ai < 2; ++ai)
#pragma unroll
            for (int m = 0; m < 4; ++m) { const size_t r = (size_t)(row0 + ai * HALF + m * 16);
#pragma unroll
                for (int bj = 0; bj < 2; ++bj) { const u32x4 g = *(const u32x4*)(gate + r * ldg + col0 + bj * HALF);
                    float gv[8] = {bf_lo(g.x), bf_hi(g.x), bf_lo(g.y), bf_hi(g.y), bf_lo(g.z), bf_hi(g.z), bf_lo(g.w), bf_hi(g.w)};
                    float o[8];
#pragma unroll
                    for (int j = 0; j < 8; ++j) { const float a = acc[ai][bj][m][j >> 2][j & 3] * ps[bj][j >> 2][j & 3]; o[j] = a * gv[j] * sigmoidf_fast(gv[j]); }
                    u32x4 w; w.x = cvt_pk_bf16(o[0], o[1]); w.y = cvt_pk_bf16(o[2], o[3]); w.z = cvt_pk_bf16(o[4], o[5]); w.w = cvt_pk_bf16(o[6], o[7]);
                    *(u32x4*)(O + r * ldc + col0 + bj * HALF) = w; }
                asm volatile("" ::: "memory"); }
    }
};
struct EpiMerge {
    static constexpr bool PERM = true, AFTER_DRAIN = false;
    bf16_t* P; const bf16_t* U; const float* bm;
    __device__ __forceinline__ void operator()(const f32x4 (&acc)[2][2][4][2], const Unit& u, int wr, int wc, int fr, int fq) const {
        const int row0 = u.pm * BM + wr * 64 + fr, col0 = u.pn * BM + wc * 32 + 8 * fq, z = u.z;
        const bf16_t* Uz = U + (size_t)z * 16384 * 4096;
        f32x4 bv[2][2];
#pragma unroll
        for (int bj = 0; bj < 2; ++bj)
#pragma unroll
            for (int n = 0; n < 2; ++n) bv[bj][n] = *(const f32x4*)(bm + z * 4096 + col0 + bj * HALF + 4 * n);
#pragma unroll
        for (int ai = 0; ai < 2; ++ai)
#pragma unroll
            for (int m = 0; m < 4; ++m) { const size_t off = (size_t)(row0 + ai * HALF + m * 16) * 4096 + col0;
#pragma unroll
                for (int bj = 0; bj < 2; ++bj) { const u32x4 uu = *(const u32x4*)(Uz + off + bj * HALF);
                    u32x4 pp = (u32x4){0u, 0u, 0u, 0u}; if (z > 0) pp = *(const u32x4*)(P + off + bj * HALF);
                    const float uv[8] = {bf_lo(uu.x), bf_hi(uu.x), bf_lo(uu.y), bf_hi(uu.y), bf_lo(uu.z), bf_hi(uu.z), bf_lo(uu.w), bf_hi(uu.w)};
                    const float pv[8] = {bf_lo(pp.x), bf_hi(pp.x), bf_lo(pp.y), bf_hi(pp.y), bf_lo(pp.z), bf_hi(pp.z), bf_lo(pp.w), bf_hi(pp.w)};
                    float o[8];
#pragma unroll
                    for (int j = 0; j < 8; ++j) o[j] = pv[j] + sigmoidf_fast(acc[ai][bj][m][j >> 2][j & 3] + bv[bj][j >> 2][j & 3]) * uv[j];
                    u32x4 w; w.x = cvt_pk_bf16(o[0], o[1]); w.y = cvt_pk_bf16(o[2], o[3]); w.z = cvt_pk_bf16(o[4], o[5]); w.w = cvt_pk_bf16(o[6], o[7]);
                    *(u32x4*)(P + off + bj * HALF) = w; }
                asm volatile("" ::: "memory"); }
    }
};
struct EpiResid {
    static constexpr bool PERM = false, AFTER_DRAIN = false;
    const float* hin; float* out;
    __device__ __forceinline__ void operator()(const f32x4 (&acc)[2][2][4][2], const Unit& u, int wr, int wc, int fr, int fq) const {
        const int row0 = u.pm * BM + wr * 64 + fr, col0 = u.pn * BM + wc * 32 + 4 * fq;
#pragma unroll
        for (int ai = 0; ai < 2; ++ai)
#pragma unroll
            for (int m = 0; m < 4; ++m) { const size_t off = (size_t)(row0 + ai * HALF + m * 16) * 4096 + col0;
#pragma unroll
                for (int bj = 0; bj < 2; ++bj)
#pragma unroll
                    for (int n = 0; n < 2; ++n) { const f32x4 hv = *(const f32x4*)(hin + off + bj * HALF + n * 16); *(f32x4*)(out + off + bj * HALF + n * 16) = hv + acc[ai][bj][m][n]; }
                asm volatile("" ::: "memory"); }
    }
};

template <class Epi, class Sched, class Ops, bool ALIGN_EPI, bool SP2>
__device__ __forceinline__ void gemm_phase(PG8_LAS unsigned char* lds, const Ops& G, const Sched& S, const Epi& E) {
    int tid_ = threadIdx.x; asm volatile("" : "+v"(tid_));
    const int tid = tid_, wid = __builtin_amdgcn_readfirstlane(tid >> 6), lane = tid & 63, wr = wid >> 2, wc = wid & 3, fr = lane & 15, fq = lane >> 4;
    const int K = G.K, nt = K / BK;
    unsigned voffA[2], voffB[2];
#pragma unroll
    for (int i = 0; i < 2; ++i) { int R, C; stage_rc(tid * 16 + i * 8192, R, C); const int Rb = Epi::PERM ? ((R & ~31) + perm32(R & 31)) : R;
        voffA[i] = (unsigned)(R * G.lda + C) * 2u; voffB[i] = (unsigned)(Rb * G.ldb + C) * 2u; }
    const size_t kstep = (size_t)(BK * 2);
    const size_t hstepA = (size_t)HALF * G.lda * 2, hstepB = (size_t)HALF * G.ldb * 2;
    const unsigned ldsw = (unsigned)wid * 1024u;
    const int aoff = lds_byte(wr * 64 + fr, fq * 8), boff = lds_byte(wc * 32 + fr, fq * 8);
#define PG8_SA(b, h) (((b) * 2 + (h)) * HTB)
#define PG8_SB(b, h) ((4 + (b) * 2 + (h)) * HTB)
#define PG8_STAGE(bufoff, gbase, voff) do { _Pragma("unroll") for (int _i = 0; _i < 2; ++_i) \
        __builtin_amdgcn_global_load_lds((const unsigned*)((const char*)(gbase) + (voff)[_i]), (PG8_LAS unsigned*)(lds + (bufoff) + ldsw + _i * 8192), 16, 0, 0); } while (0)
#define PG8_LDA(dst, b, h) do { _Pragma("unroll") for (int m = 0; m < 4; ++m) _Pragma("unroll") for (int k = 0; k < 2; ++k) dst[m][k] = *(const PG8_LAS bf16x8*)(lds + PG8_SA(b, h) + aoff + m * 2048 + k * 1024); } while (0)
#define PG8_LDB(dst, b, h) do { _Pragma("unroll") for (int n = 0; n < 2; ++n) _Pragma("unroll") for (int k = 0; k < 2; ++k) dst[n][k] = *(const PG8_LAS bf16x8*)(lds + PG8_SB(b, h) + boff + n * 2048 + k * 1024); } while (0)
#define PG8_MMA(ai, bj, At, Bt) do { __builtin_amdgcn_s_setprio(1); _Pragma("unroll") for (int m = 0; m < 4; ++m) _Pragma("unroll") for (int n = 0; n < 2; ++n) _Pragma("unroll") for (int k = 0; k < 2; ++k) \
        acc[ai][bj][m][n] = __builtin_amdgcn_mfma_f32_16x16x32_bf16(Bt[n][k], At[m][k], acc[ai][bj][m][n], 0, 0, 0); __builtin_amdgcn_s_setprio(0); } while (0)
#define PG8_WAIT_V(n) asm volatile("s_waitcnt vmcnt(" #n ")" ::: "memory")
#define PG8_WAIT_L(n) asm volatile("s_waitcnt lgkmcnt(" #n ")" ::: "memory")
#define PG8_BAR __builtin_amdgcn_s_barrier()
#define PG8_SCHED __builtin_amdgcn_sched_barrier(0)
    Unit cur, nxt; int ui = 0;
    if (!S.next(0, cur)) return;
    f32x4 acc[2][2][4][2];
#pragma unroll
    for (int a = 0; a < 2; ++a)
#pragma unroll
        for (int b = 0; b < 2; ++b)
#pragma unroll
            for (int m = 0; m < 4; ++m)
#pragma unroll
                for (int n = 0; n < 2; ++n) acc[a][b][m][n] = (f32x4){0.f, 0.f, 0.f, 0.f};
    bf16x8 At[4][2], B0[2][2], B1[2][2];
    const char* cA = G.a_ptr(cur); const char* cB = G.b_ptr(cur);
    S.a_ready(cur);
    if constexpr (SP2) {
        PG8_STAGE(PG8_SB(0, 0), cB, voffB); PG8_STAGE(PG8_SB(0, 1), cB + hstepB, voffB); PG8_STAGE(PG8_SA(0, 0), cA, voffA); PG8_STAGE(PG8_SA(0, 1), cA + hstepA, voffA);
        if (wr == 1) PG8_BAR;
        PG8_WAIT_V(2); PG8_BAR;
        PG8_STAGE(PG8_SB(1, 0), cB + kstep, voffB); PG8_STAGE(PG8_SA(1, 0), cA + kstep, voffA); PG8_STAGE(PG8_SB(1, 1), cB + hstepB + kstep, voffB);
        PG8_WAIT_V(6); PG8_BAR;
    } else {
        PG8_STAGE(PG8_SB(0, 0), cB, voffB); PG8_STAGE(PG8_SA(0, 0), cA, voffA); PG8_STAGE(PG8_SB(0, 1), cB + hstepB, voffB); PG8_STAGE(PG8_SA(0, 1), cA + hstepA, voffA);
        if (wr == 1) PG8_BAR;
        PG8_WAIT_V(4); PG8_BAR;
        PG8_STAGE(PG8_SB(1, 0), cB + kstep, voffB); PG8_STAGE(PG8_SA(1, 0), cA + kstep, voffA); PG8_STAGE(PG8_SB(1, 1), cB + hstepB + kstep, voffB);
        PG8_WAIT_V(6); PG8_BAR;
    }
    for (;;) {
        const bool has_next = S.next(ui + 1, nxt);
        const char* nA = has_next ? G.a_ptr(nxt) : cA; const char* nB = has_next ? G.b_ptr(nxt) : cB;
        for (int t = 0; t < nt; t += 2) {
            const bool last = (t == nt - 2);
            const char* a1 = cA + (size_t)(t + 1) * kstep;
            const char* a2 = last ? nA : cA + (size_t)(t + 2) * kstep; const char* b2 = last ? nB : cB + (size_t)(t + 2) * kstep;
            const char* a3 = a2 + kstep; const char* b3 = b2 + kstep;
            if (last && has_next) S.a_ready(nxt);
            if constexpr (SP2) {
            PG8_LDB(B0, 0, 0); PG8_LDB(B1, 0, 1); PG8_SCHED; PG8_LDA(At, 0, 0); PG8_STAGE(PG8_SA(1, 1), a1 + hstepA, voffA);
            PG8_WAIT_V(8); PG8_WAIT_L(0); PG8_BAR; PG8_MMA(0, 0, At, B0); PG8_MMA(0, 1, At, B1); PG8_BAR; PG8_SCHED;
            PG8_LDA(At, 0, 1); PG8_STAGE(PG8_SB(0, 0), b2, voffB); PG8_STAGE(PG8_SB(0, 1), b2 + hstepB, voffB); PG8_STAGE(PG8_SA(0, 0), a2, voffA);
            PG8_WAIT_V(8); PG8_WAIT_L(0); PG8_BAR; PG8_MMA(1, 0, At, B0); PG8_MMA(1, 1, At, B1); PG8_BAR; PG8_SCHED;
            PG8_LDB(B0, 1, 0); PG8_LDB(B1, 1, 1); PG8_SCHED; PG8_LDA(At, 1, 0); PG8_STAGE(PG8_SA(0, 1), a2 + hstepA, voffA);
            PG8_WAIT_V(8); PG8_WAIT_L(0); PG8_BAR; PG8_MMA(0, 0, At, B0); PG8_MMA(0, 1, At, B1); PG8_BAR; PG8_SCHED;
            PG8_LDA(At, 1, 1); PG8_STAGE(PG8_SB(1, 0), b3, voffB); PG8_STAGE(PG8_SB(1, 1), b3 + hstepB, voffB); PG8_STAGE(PG8_SA(1, 0), a3, voffA);
            PG8_WAIT_V(8); PG8_WAIT_L(0); PG8_BAR; PG8_MMA(1, 0, At, B0); PG8_MMA(1, 1, At, B1); PG8_BAR; PG8_SCHED;
            } else {
            PG8_LDB(B0, 0, 0); PG8_SCHED; PG8_LDA(At, 0, 0); PG8_STAGE(PG8_SA(1, 1), a1 + hstepA, voffA);
            PG8_WAIT_L(8); PG8_BAR; PG8_WAIT_L(0); PG8_MMA(0, 0, At, B0); PG8_BAR; PG8_SCHED;
            PG8_LDB(B1, 0, 1); PG8_STAGE(PG8_SB(0, 0), b2, voffB);
            PG8_BAR; PG8_WAIT_L(0); PG8_MMA(0, 1, At, B1); PG8_BAR;
            PG8_LDA(At, 0, 1); PG8_STAGE(PG8_SA(0, 0), a2, voffA);
            PG8_BAR; PG8_WAIT_L(0); PG8_MMA(1, 0, At, B0); PG8_BAR; PG8_SCHED;
            PG8_STAGE(PG8_SB(0, 1), b2 + hstepB, voffB);
            PG8_WAIT_V(6); PG8_BAR; PG8_MMA(1, 1, At, B1); PG8_BAR;
            PG8_LDB(B0, 1, 0); PG8_SCHED; PG8_LDA(At, 1, 0); PG8_STAGE(PG8_SA(0, 1), a2 + hstepA, voffA);
            PG8_WAIT_L(8); PG8_BAR; PG8_WAIT_L(0); PG8_MMA(0, 0, At, B0); PG8_BAR; PG8_SCHED;
            PG8_LDB(B1, 1, 1); PG8_STAGE(PG8_SB(1, 0), b3, voffB);
            PG8_BAR; PG8_WAIT_L(0); PG8_MMA(0, 1, At, B1); PG8_BAR;
            PG8_LDA(At, 1, 1); PG8_STAGE(PG8_SA(1, 0), a3, voffA);
            PG8_BAR; PG8_WAIT_L(0); PG8_MMA(1, 0, At, B0); PG8_BAR; PG8_SCHED;
            PG8_STAGE(PG8_SB(1, 1), b3 + hstepB, voffB);
            PG8_WAIT_V(6); PG8_BAR; PG8_MMA(1, 1, At, B1); PG8_BAR;
            }
        }
        if constexpr (ALIGN_EPI) { if (wr == 0) PG8_BAR; }
        if constexpr (!Epi::AFTER_DRAIN) { E(acc, cur, wr, wc, fr, fq); S.done(cur); }
        if (!has_next) break;
#pragma unroll
        for (int a = 0; a < 2; ++a)
#pragma unroll
            for (int b = 0; b < 2; ++b)
#pragma unroll
                for (int m = 0; m < 4; ++m)
#pragma unroll
                    for (int n = 0; n < 2; ++n) acc[a][b][m][n] = (f32x4){0.f, 0.f, 0.f, 0.f};
        cur = nxt; cA = nA; cB = nB; ++ui;
        if constexpr (ALIGN_EPI) { if (wr == 1) PG8_BAR; }
    }
    PG8_WAIT_V(0);
    if constexpr (!ALIGN_EPI) { if (wr == 0) PG8_BAR; }
    PG8_BAR;
    if constexpr (Epi::AFTER_DRAIN) { E.fused(acc, cur, wr, wc, fr, fq, lds, wid, lane); S.done(cur); }
#undef PG8_SA
#undef PG8_SB
#undef PG8_STAGE
#undef PG8_LDA
#undef PG8_LDB
#undef PG8_MMA
#undef PG8_WAIT_V
#undef PG8_WAIT_L
#undef PG8_BAR
#undef PG8_SCHED
}
}
#define GAS __attribute__((address_space(1)))
#define LAS __attribute__((address_space(3)))
typedef unsigned short bf16;
typedef unsigned v4u __attribute__((ext_vector_type(4)));
typedef float f32x4 __attribute__((ext_vector_type(4)));
typedef short bf16x8 __attribute__((ext_vector_type(8)));
typedef GAS unsigned gu32;
typedef GAS unsigned long long gu64;
#define RLX_AGENT __ATOMIC_RELAXED, __HIP_MEMORY_SCOPE_AGENT
#define LDS_WAIT() asm volatile("s_waitcnt lgkmcnt(0)" ::: "memory")
#define VM_WAIT() asm volatile("s_waitcnt vmcnt(0)" ::: "memory")
__device__ __forceinline__ unsigned long long rt() { return __builtin_amdgcn_s_memrealtime(); }
__device__ __forceinline__ unsigned f2bf(float f) { unsigned u = __builtin_bit_cast(unsigned, f); return (u + 0x7fffu + ((u >> 16) & 1u)) >> 16; }
__device__ __forceinline__ unsigned pk2(float lo, float hi) { return f2bf(lo) | (f2bf(hi) << 16); }

#define XB_TMO      128
#define XB_XCNT(j)  (256  + 64 * (j))
#define XB_XSUB(j)  (1280 + 64 * (j))
#define XB_XGEN(j)  (2304 + 64 * (j))
#define XB_TOP      3328
#define XB_TOPGEN   3392
#define XCD_BAR_WORDS 3456
#define XB_SPIN_CAP (1u << 18)

__device__ __forceinline__ unsigned xb_ld(unsigned* p)              { return __hip_atomic_load(p, __ATOMIC_RELAXED, __HIP_MEMORY_SCOPE_AGENT); }
__device__ __forceinline__ unsigned xb_add(unsigned* p, unsigned v) { return __hip_atomic_fetch_add(p, v, __ATOMIC_RELAXED, __HIP_MEMORY_SCOPE_AGENT); }
__device__ __forceinline__ unsigned xb_xcc_id() { return (unsigned)__builtin_amdgcn_s_getreg((3 << 11) | 20) & 0xFu; }
#define XB_SPIN(cond, bar) do { unsigned _sp = 0; while (cond) { __builtin_amdgcn_s_sleep(1); \
    if ((++_sp & 255u) == 0u) { if (xb_ld(&(bar)[XB_TMO])) break; if (_sp > XB_SPIN_CAP) { atomicAdd(&(bar)[XB_TMO], 1u); break; } } } } while (0)

struct XcdBarrier {
    unsigned* bar; unsigned x;
    volatile LAS unsigned* st;
};

__device__ __forceinline__ XcdBarrier xcd_barrier_post(unsigned* bar, volatile LAS unsigned* st) {
    XcdBarrier b; b.bar = bar; b.x = xb_xcc_id(); b.st = st;
    if (threadIdx.x == 0) (void)xb_add(&bar[XB_XCNT(b.x)], 1u);
    return b;
}
__device__ __forceinline__ void xcd_barrier_complete(unsigned* bar, unsigned x, unsigned& nloc, unsigned& nx) {
    const unsigned G = gridDim.x * gridDim.y * gridDim.z;
    unsigned sum, cnt, mine, sp = 0u;
    for (;;) {
        sum = 0u; cnt = 0u; mine = 0u;
#pragma unroll
        for (unsigned j = 0; j < 16; ++j) { const unsigned c = xb_ld(&bar[XB_XCNT(j)]); sum += c; cnt += (c > 0u) ? 1u : 0u; mine = (j == x) ? c : mine; }
        if (sum == G) break;
        __builtin_amdgcn_s_sleep(1);
        if ((++sp & 255u) == 0u) { if (xb_ld(&bar[XB_TMO])) break; if (sp > XB_SPIN_CAP) { atomicAdd(&bar[XB_TMO], 1u); break; } }
    }
    nloc = mine > 0u ? mine : 1u; nx = cnt > 0u ? cnt : 1u;
}

__device__ __forceinline__ void xcd_barrier(const XcdBarrier& b) {
    asm volatile("s_waitcnt vmcnt(0)" ::: "memory");
    __syncthreads();
    if (threadIdx.x == 0) {
        unsigned* bar = b.bar;
        __builtin_amdgcn_s_waitcnt(0);
        unsigned nloc = b.st[0], nx = b.st[1];
        if (nloc == 0u) { xcd_barrier_complete(bar, b.x, nloc, nx); b.st[0] = nloc; b.st[1] = nx; }
        const unsigned old = xb_add(&bar[XB_XSUB(b.x)], 1u);
        const unsigned gen = old / nloc;
        if (old + 1u == (gen + 1u) * nloc) {
            __builtin_amdgcn_fence(__ATOMIC_RELEASE, "agent");
            asm volatile("s_waitcnt vmcnt(0)" ::: "memory");
            const unsigned og = xb_add(&bar[XB_TOP], 1u);
            const unsigned tg = og / nx;
            if (og + 1u == (tg + 1u) * nx) xb_add(&bar[XB_TOPGEN], 1u);
            else XB_SPIN(xb_ld(&bar[XB_TOPGEN]) == tg, bar);
            __builtin_amdgcn_fence(__ATOMIC_ACQUIRE, "agent");
            xb_add(&bar[XB_XGEN(b.x)], 1u);
            asm volatile("s_waitcnt vmcnt(0)" ::: "memory");
        } else {
            XB_SPIN(xb_ld(&bar[XB_XGEN(b.x)]) == gen, bar);
            __builtin_amdgcn_fence(__ATOMIC_ACQUIRE, "agent");
            asm volatile("s_waitcnt vmcnt(0)" ::: "memory");
        }
    }
    __syncthreads();
}

constexpr int BATCH = 2, SEQ = 8192, DM = 4096, M = BATCH * SEQ, NIN = 30728, BW = 1024, NH = 8, HD = 128, NBLK = SEQ / 256, DEPTH = 2;
constexpr int N1 = 14336;
constexpr int A_Q = 0, A_K = 1024, A_V = 2048, A_G = 3072, B_Q = 4096, B_K = 5120, B_V = 6144, B_G = 7168, C_IN = 8192, C_G = 9216, D_B = 10240, D_C = 11264, D_X = 12288, D_G = 13312;
constexpr int SRC_FORGET = 8192, SRC_SEG2 = 8200, SRC_MERGE = 14344;
constexpr float RMS_EPS = 1e-6f;
constexpr int NWAVES = 8, NTHR = 512;

constexpr size_t MiB = 1ull << 20;
constexpr size_t WS_CTL = 0, CTL_ZERO_BYTES = 1 * MiB;
constexpr size_t W1T_L = (size_t)N1 * DM * 2, WG_L = (size_t)4 * DM * DM * 2, WB_L = (size_t)4 * DM * BW * 2, WO_L = (size_t)DM * DM * 2, WP_L = (size_t)4 * 256 * 256 * 2;
constexpr size_t WS_W1T = 1 * MiB;
constexpr size_t WS_WG = WS_W1T + 2 * W1T_L;
constexpr size_t WS_WB = WS_WG + 2 * WG_L;
constexpr size_t WS_WO = WS_WB + 2 * WB_L;
constexpr size_t WS_WP = WS_WO + 2 * WO_L;
constexpr size_t WS_HN = WS_WP + 2 * WP_L;
constexpr size_t WS_PROJ = WS_HN + (size_t)M * DM * 2;
constexpr size_t WS_BR = WS_PROJ + (size_t)M * N1 * 2;
constexpr size_t WS_U = WS_BR + (size_t)4 * M * BW * 2;
constexpr size_t WS_MG = WS_U + (size_t)4 * M * DM * 2;
constexpr size_t WS_POOLED = WS_MG + (size_t)M * DM * 2;
constexpr size_t WS_LF = WS_POOLED + (size_t)M * BW * 2;
constexpr size_t WS_C32 = WS_LF + MiB;
constexpr size_t WS_BIAS = WS_C32 + MiB;
constexpr size_t WS_KMEAN = WS_BIAS + 2 * MiB;
constexpr size_t WS_SEL = WS_KMEAN + MiB;
constexpr size_t WS_END = WS_SEL + MiB;
constexpr int CW_BAR = 4096;

constexpr int RING_BYTES = 131072, LDSCTL_OFF = RING_BYTES, MISC_OFF = LDSCTL_OFF + 320, LDS_BYTES = 147456;

__device__ __forceinline__ float wave_sum(float v) {
#pragma unroll
    for (int o = 1; o < 64; o <<= 1) v += __shfl_xor(v, o);
    return v;
}
__device__ __forceinline__ float bf2f(unsigned short b) { return __uint_as_float(((unsigned)b) << 16); }
__device__ __forceinline__ float siluf(float x) { return x * pg8::sigmoidf_fast(x); }

__device__ __forceinline__ void tr_item(const float* src, size_t ldw, bf16* dst, size_t ldt, LAS float* scr, int lane) {
#pragma unroll 8
    for (int i = 0; i < 32; ++i) { const int kk = 2 * i + (lane >> 5); scr[kk * 33 + (lane & 31)] = src[(size_t)kk * ldw + (lane & 31)]; }
    LDS_WAIT(); asm volatile("" ::: "memory");
    const int c = lane & 7;
#pragma unroll
    for (int j = 0; j < 4; ++j) { const int n = (lane >> 3) + 8 * j; const LAS float* s = scr + (8 * c) * 33 + n;
        v4u o; o.x = pk2(s[0 * 33], s[1 * 33]); o.y = pk2(s[2 * 33], s[3 * 33]); o.z = pk2(s[4 * 33], s[5 * 33]); o.w = pk2(s[6 * 33], s[7 * 33]);
        *(GAS v4u*)(dst + (size_t)n * ldt + 8 * c) = o; }
    LDS_WAIT(); asm volatile("" ::: "memory");
}
constexpr int IT_W1A = 64 * 256, IT_W1B = 64 * 192, IT_WG = 64 * 512, IT_WB = 4 * 16 * 128, IT_WO = 64 * 128, IT_WP = 4 * 4 * 8;
constexpr int IT_LAYER = IT_W1A + IT_W1B + IT_WG + IT_WB + IT_WO + IT_WP;

struct Args { const float* in[11]; float* out; unsigned char* ws; int ph_lo, ph_hi; };

struct OpsPlain { const char* A; const char* Bt; int K, lda, ldb;
    __device__ __forceinline__ const char* a_ptr(const pg8::Unit& u) const { return A + (size_t)u.pm * 256 * lda * 2; }
    __device__ __forceinline__ const char* b_ptr(const pg8::Unit& u) const { return Bt + (size_t)u.pn * 256 * ldb * 2; } };
struct OpsUp { const char* A; const char* Bt; int K, lda, ldb;
    __device__ __forceinline__ const char* a_ptr(const pg8::Unit& u) const { return A + (size_t)u.pm * 256 * 1024 * 2; }
    __device__ __forceinline__ const char* b_ptr(const pg8::Unit& u) const { return Bt + ((size_t)(u.pm >> 6) * 4096 + (size_t)u.pn * 256) * 1024 * 2; } };
struct OpsMerge { const char* A; const char* Bt; int K, lda, ldb;
    __device__ __forceinline__ const char* a_ptr(const pg8::Unit& u) const { return A + (size_t)u.pm * 256 * 4096 * 2; }
    __device__ __forceinline__ const char* b_ptr(const pg8::Unit& u) const { return Bt + ((size_t)u.z * 4096 + (size_t)u.pn * 256) * 4096 * 2; } };
struct OpsPool { const char* A; const char* Bt; int K, lda, ldb;
    __device__ __forceinline__ const char* a_ptr(const pg8::Unit& u) const { return A + (size_t)u.pm * 256 * 1024 * 2 + (size_t)u.pn * 256 * 2; }
    __device__ __forceinline__ const char* b_ptr(const pg8::Unit& u) const { return Bt + (size_t)u.pn * 256 * 256 * 2; } };

constexpr int NPL = 8, PH_FINAL = 1 + DEPTH * NPL, N_PHASES = PH_FINAL + 1;
#ifndef PH_MASK
#define PH_MASK 0x3ff
#endif
#define PHEN(k) (((PH_MASK) >> (k)) & 1)
#ifndef ATTN_IN_KERNEL
#define ATTN_IN_KERNEL 0
#endif

__global__ void __launch_bounds__(NTHR, 2) fwd(Args args) {
    extern __shared__ __attribute__((aligned(16))) unsigned char lds_raw[];
    LAS unsigned char* lds = (LAS unsigned char*)lds_raw;
    volatile LAS unsigned* MISC = (volatile LAS unsigned*)(lds + MISC_OFF);
    const int tid = threadIdx.x, lane = tid & 63, wave = __builtin_amdgcn_readfirstlane(tid >> 6);
    const int G = gridDim.x, bx = blockIdx.x;
    unsigned char* ws = args.ws;
    gu32* ctl = (gu32*)(ws + WS_CTL);
    const float* x = args.in[0]; const float* norm_g = args.in[1]; const float* w_in = args.in[2]; const float* b_forget = args.in[3]; const float* w_pool = args.in[4];
    const float* pool_scale = args.in[5]; const float* w_conv = args.in[6]; const float* w_branch = args.in[7]; const float* b_merge = args.in[8]; const float* w_out = args.in[9];
    const float* final_g = args.in[10]; float* out = args.out;
    bf16* HN = (bf16*)(ws + WS_HN); bf16* PROJ = (bf16*)(ws + WS_PROJ); bf16* BR = (bf16*)(ws + WS_BR); bf16* U = (bf16*)(ws + WS_U); bf16* MG = (bf16*)(ws + WS_MG); bf16* POOLED = (bf16*)(ws + WS_POOLED);
    float* LF = (float*)(ws + WS_LF); float* C32 = (float*)(ws + WS_C32); v4u* BIAS = (v4u*)(ws + WS_BIAS); float* KMEAN = (float*)(ws + WS_KMEAN); unsigned* SEL = (unsigned*)(ws + WS_SEL);
    for (int u = tid; u < (LDS_BYTES - LDSCTL_OFF) / 4; u += NTHR) ((LAS unsigned*)(lds + LDSCTL_OFF))[u] = 0u;
    __syncthreads();
    const int lo = args.ph_lo, hi = args.ph_hi;
    const bool multi = (hi - lo) > 1;
    XcdBarrier bar; bar.bar = (unsigned*)(ctl + CW_BAR); bar.x = 0; bar.st = nullptr;
    if (multi) bar = xcd_barrier_post((unsigned*)(ctl + CW_BAR), MISC + 8);
#define IN(k) (lo <= (k) && (k) < hi)
#define SEAM(k) do { if (IN(k) && IN((k) + 1)) xcd_barrier(bar); } while (0)
    const int NGW = G * NWAVES;
#define PHASE_IDS int tid_o = threadIdx.x; asm volatile("" : "+v"(tid_o)); const int tid = tid_o, lane = tid & 63, wave = __builtin_amdgcn_readfirstlane(tid >> 6), gw = bx * NWAVES + wave; (void)lane; (void)gw;

    if (PHEN(0) && IN(0)) { PHASE_IDS
        LAS float* scr = (LAS float*)(lds + wave * 16384);
        for (int it = gw; it < DEPTH * IT_LAYER; it += NGW) {
            const int l = it / IT_LAYER; int r = it - l * IT_LAYER;
            const float* win_l = w_in + (size_t)l * DM * NIN;
            if (r < IT_W1A) { const int kb = r / 256, nb = r % 256; tr_item(win_l + (size_t)kb * 64 * NIN + nb * 32, NIN, (bf16*)(ws + WS_W1T + l * W1T_L) + (size_t)(nb * 32) * DM + kb * 64, DM, scr, lane); continue; } r -= IT_W1A;
            if (r < IT_W1B) { const int kb = r / 192, nb = r % 192; tr_item(win_l + (size_t)kb * 64 * NIN + SRC_SEG2 + nb * 32, NIN, (bf16*)(ws + WS_W1T + l * W1T_L) + (size_t)(8192 + nb * 32) * DM + kb * 64, DM, scr, lane); continue; } r -= IT_W1B;
            if (r < IT_WG) { const int kb = r / 512, nb = r % 512; tr_item(win_l + (size_t)kb * 64 * NIN + SRC_MERGE + nb * 32, NIN, (bf16*)(ws + WS_WG + l * WG_L) + (size_t)(nb * 32) * DM + kb * 64, DM, scr, lane); continue; } r -= IT_WG;
            if (r < IT_WB) { const int i = r / 2048, r2 = r % 2048, kb = r2 / 128, nb = r2 % 128;
                tr_item(w_branch + ((size_t)(l * 4 + i) * BW + kb * 64) * DM + nb * 32, DM, (bf16*)(ws + WS_WB + l * WB_L) + ((size_t)i * DM + nb * 32) * BW + kb * 64, BW, scr, lane); continue; } r -= IT_WB;
            if (r < IT_WO) { const int kb = r / 128, nb = r % 128; tr_item(w_out + ((size_t)l * DM + kb * 64) * DM + nb * 32, DM, (bf16*)(ws + WS_WO + l * WO_L) + (size_t)(nb * 32) * DM + kb * 64, DM, scr, lane); continue; } r -= IT_WO;
            { const int g = r / 32, r2 = r % 32, kb = r2 / 8, nb = r2 % 8;
              tr_item(w_pool + ((size_t)(l * 4 + g) * 256 + kb * 64) * 256 + nb * 32, 256, (bf16*)(ws + WS_WP + l * WP_L) + ((size_t)g * 256 + nb * 32) * 256 + kb * 64, 256, scr, lane); }
        }
    }
    SEAM(0);

    for (int l = 0; l < DEPTH; ++l) {
        const int pb = 1 + l * NPL;
        const float* hin = (l == 0) ? x : out;
        const float* win_l = w_in + (size_t)l * DM * NIN;

        if (PHEN(1) && IN(pb + 0)) { PHASE_IDS
            LAS float* wfT = (LAS float*)lds;
            for (int k = tid; k < DM; k += NTHR) { const f32x4 a = *(const f32x4*)(win_l + (size_t)k * NIN + SRC_FORGET), b = *(const f32x4*)(win_l + (size_t)k * NIN + SRC_FORGET + 4);
                wfT[0 * DM + k] = a.x; wfT[1 * DM + k] = a.y; wfT[2 * DM + k] = a.z; wfT[3 * DM + k] = a.w; wfT[4 * DM + k] = b.x; wfT[5 * DM + k] = b.y; wfT[6 * DM + k] = b.z; wfT[7 * DM + k] = b.w; }
            __syncthreads();
            const f32x4* g4 = (const f32x4*)(norm_g + (size_t)l * DM);
            for (int row = gw; row < M; row += NGW) {
                const f32x4* xr = (const f32x4*)(hin + (size_t)row * DM);
                f32x4 v[16]; float ss = 0.f;
#pragma unroll
                for (int j = 0; j < 16; ++j) { v[j] = xr[lane + 64 * j]; ss += (v[j].x * v[j].x + v[j].y * v[j].y) + (v[j].z * v[j].z + v[j].w * v[j].w); }
                const float rstd = 1.0f / sqrtf(wave_sum(ss) * (1.0f / DM) + RMS_EPS);
                float fa[8] = {0.f, 0.f, 0.f, 0.f, 0.f, 0.f, 0.f, 0.f};
                unsigned long long* o8 = (unsigned long long*)(HN + (size_t)row * DM);
#pragma unroll
                for (int j = 0; j < 16; ++j) { const f32x4 gg = g4[lane + 64 * j]; const f32x4 y = v[j] * rstd * gg;
                    o8[lane + 64 * j] = (unsigned long long)pk2(y.x, y.y) | ((unsigned long long)pk2(y.z, y.w) << 32);
#pragma unroll
                    for (int h = 0; h < 8; ++h) { const f32x4 w = *(const LAS f32x4*)(wfT + h * DM + 4 * (lane + 64 * j)); fa[h] += (y.x * w.x + y.y * w.y) + (y.z * w.z + y.w * w.w); }
                    asm volatile("" ::: "memory"); }
#pragma unroll
                for (int h = 0; h < 8; ++h) fa[h] = wave_sum(fa[h]);
                float mine = fa[0];
#pragma unroll
                for (int h = 1; h < 8; ++h) mine = (lane == h) ? fa[h] : mine;
                if (lane < 8) { const float z = mine + b_forget[l * NH + lane]; const float ls = fminf(z, 0.f) - log1pf(expf(-fabsf(z)));
                    LF[((size_t)(row / SEQ) * NH + lane) * SEQ + (row % SEQ)] = ls; }
            }
        }
        SEAM(pb + 0);

        if (PHEN(2) && IN(pb + 1)) {
            OpsPlain O{(const char*)HN, (const char*)(ws + WS_W1T + l * W1T_L), DM, DM, DM};
            pg8::StaticOrder S; S.init(M, N1, G, bx);
            pg8::EpiStoreBf16 E{PROJ, N1};
            pg8::gemm_phase<pg8::EpiStoreBf16, pg8::StaticOrder, OpsPlain, true, true>(lds, O, S, E);
        }
        SEAM(pb + 1);

        if (PHEN(3) && IN(pb + 2)) { PHASE_IDS
            { LAS float* red = (LAS float*)lds;
              for (int ua = bx; ua < BATCH * NBLK * NH; ua += G) { const int b = ua >> 8, n = (ua >> 3) & 31, h = ua & 7; const int cp = tid & 63, rg = tid >> 6;
                const bf16* base = PROJ + (size_t)(b * SEQ + n * 256 + rg * 32) * N1 + A_K + h * HD + 2 * cp; float s0 = 0.f, s1 = 0.f;
#pragma unroll 8
                for (int r = 0; r < 32; ++r) { const unsigned w = *(const unsigned*)(base + (size_t)r * N1); s0 += pg8::bf_lo(w); s1 += pg8::bf_hi(w); }
                red[rg * 128 + 2 * cp] = s0; red[rg * 128 + 2 * cp + 1] = s1; __syncthreads();
                if (tid < 128) { float s = 0.f;
#pragma unroll
                    for (int q = 0; q < 8; ++q) s += red[q * 128 + tid];
                    KMEAN[((size_t)(b * NH + h) * NBLK + n) * HD + tid] = s * (1.0f / 256.0f); }
                __syncthreads(); } }
            { LAS double* sd = (LAS double*)lds;
              for (int ub = G - 1 - bx; ub < BATCH * NH; ub += G) { const float* lf = LF + (size_t)ub * SEQ + 16 * tid; double loc[16]; double run = 0.0;
#pragma unroll
                for (int k = 0; k < 16; ++k) { run += (double)lf[k]; loc[k] = run; }
                sd[tid] = run; __syncthreads();
                for (int off = 1; off < NTHR; off <<= 1) { const double vv = (tid >= off) ? sd[tid - off] : 0.0; __syncthreads(); sd[tid] += vv; __syncthreads(); }
                const double excl = sd[tid] - run;
#pragma unroll
                for (int k = 0; k < 16; ++k) { const double c = excl + loc[k]; C32[(size_t)ub * SEQ + 16 * tid + k] = (float)c;
                    const double xx = -c * 11.313708498984761; const unsigned b1 = f2bf((float)xx); const double r1 = xx - (double)__uint_as_float(b1 << 16);
                    const unsigned b2 = f2bf((float)r1); const double r2 = r1 - (double)__uint_as_float(b2 << 16); const unsigned b3 = f2bf((float)r2);
                    BIAS[(size_t)ub * SEQ + 16 * tid + k] = (v4u){b1 | (b2 << 16), b3, 0u, 0u}; }
                __syncthreads(); } }
            { const float* wc_l = w_conv + (size_t)l * 3 * BW;
              for (int idx = bx * NTHR + tid; idx < M * 128; idx += G * NTHR) { const int row = idx >> 7, col = (idx & 127) * 8, t = row & (SEQ - 1);
                { const int win = 2 << (col >> 8), nw = (t + 1 < win) ? t + 1 : win; float s[8] = {0.f, 0.f, 0.f, 0.f, 0.f, 0.f, 0.f, 0.f}; float u0[8];
                  const bf16* p = PROJ + (size_t)row * N1 + C_IN + col;
                  for (int j = 0; j < nw; ++j) { const v4u w = *(const v4u*)(p - (size_t)j * N1); const float f[8] = {pg8::bf_lo(w.x), pg8::bf_hi(w.x), pg8::bf_lo(w.y), pg8::bf_hi(w.y), pg8::bf_lo(w.z), pg8::bf_hi(w.z), pg8::bf_lo(w.w), pg8::bf_hi(w.w)};
#pragma unroll
                      for (int e = 0; e < 8; ++e) { s[e] += f[e]; if (j == 0) u0[e] = f[e]; } }
                  const float inv = 1.0f / (float)nw; float o[8];
#pragma unroll
                  for (int e = 0; e < 8; ++e) o[e] = s[e] * inv - u0[e];
                  *(v4u*)(POOLED + (size_t)row * BW + col) = (v4u){pk2(o[0], o[1]), pk2(o[2], o[3]), pk2(o[4], o[5]), pk2(o[6], o[7])}; }
                { float y[8] = {0.f, 0.f, 0.f, 0.f, 0.f, 0.f, 0.f, 0.f};
#pragma unroll
                  for (int k = 0; k < 3; ++k) { const int dt = 2 - k; if (t - dt >= 0) { const bf16* pr = PROJ + (size_t)(row - dt) * N1 + col; const v4u cw = *(const v4u*)(pr + D_C), xw = *(const v4u*)(pr + D_X);
                      const f32x4 w0 = *(const f32x4*)(wc_l + k * BW + col), w1 = *(const f32x4*)(wc_l + k * BW + col + 4);
                      y[0] += w0.x * pg8::bf_lo(cw.x) * pg8::bf_lo(xw.x); y[1] += w0.y * pg8::bf_hi(cw.x) * pg8::bf_hi(xw.x); y[2] += w0.z * pg8::bf_lo(cw.y) * pg8::bf_lo(xw.y); y[3] += w0.w * pg8::bf_hi(cw.y) * pg8::bf_hi(xw.y);
                      y[4] += w1.x * pg8::bf_lo(cw.z) * pg8::bf_lo(xw.z); y[5] += w1.y * pg8::bf_hi(cw.z) * pg8::bf_hi(xw.z); y[6] += w1.z * pg8::bf_lo(cw.w) * pg8::bf_lo(xw.w); y[7] += w1.w * pg8::bf_hi(cw.w) * pg8::bf_hi(xw.w); } }
                  const bf16* pr = PROJ + (size_t)row * N1 + col; const v4u bw = *(const v4u*)(pr + D_B), gwv = *(const v4u*)(pr + D_G);
                  const float bb[8] = {pg8::bf_lo(bw.x), pg8::bf_hi(bw.x), pg8::bf_lo(bw.y), pg8::bf_hi(bw.y), pg8::bf_lo(bw.z), pg8::bf_hi(bw.z), pg8::bf_lo(bw.w), pg8::bf_hi(bw.w)};
                  const float gg[8] = {pg8::bf_lo(gwv.x), pg8::bf_hi(gwv.x), pg8::bf_lo(gwv.y), pg8::bf_hi(gwv.y), pg8::bf_lo(gwv.z), pg8::bf_hi(gwv.z), pg8::bf_lo(gwv.w), pg8::bf_hi(gwv.w)};
                  float o[8];
#pragma unroll
                  for (int e = 0; e < 8; ++e) o[e] = bb[e] * y[e] * siluf(gg[e]);
                  *(v4u*)(BR + ((size_t)3 * M + row) * BW + col) = (v4u){pk2(o[0], o[1]), pk2(o[2], o[3]), pk2(o[4], o[5]), pk2(o[6], o[7])}; }
              } }
        }
        SEAM(pb + 2);

        if (PHEN(4) && IN(pb + 3)) { PHASE_IDS
            { LAS float* km = (LAS float*)lds;
              for (int us = bx; us < BATCH * NH * 16; us += G) { const int b = us >> 7, h = (us >> 4) & 7, qp = us & 15; const int t = qp * 512 + tid, qb = t >> 8, nneed = 2 * qp + 1;
                const float* ksrc = KMEAN + (size_t)(b * NH + h) * NBLK * HD;
                for (int i = tid; i < nneed * HD; i += NTHR) km[i] = ksrc[i];
                __syncthreads();
                const size_t row = (size_t)b * SEQ + t; const v4u* qp4 = (const v4u*)(PROJ + row * N1 + A_Q + h * HD); v4u qv[16];
#pragma unroll
                for (int i = 0; i < 16; ++i) qv[i] = qp4[i];
                float v0 = -3.0e38f, v1 = -3.0e38f, v2 = -3.0e38f; int i0 = -1, i1 = -1, i2 = -1;
                for (int n = 0; n < qb; ++n) { float s = 0.f; const LAS f32x4* kr = (const LAS f32x4*)(km + n * HD);
#pragma unroll
                    for (int i = 0; i < 16; ++i) { const f32x4 ka = kr[2 * i], kb = kr[2 * i + 1];
                        s += pg8::bf_lo(qv[i].x) * ka.x; s += pg8::bf_hi(qv[i].x) * ka.y; s += pg8::bf_lo(qv[i].y) * ka.z; s += pg8::bf_hi(qv[i].y) * ka.w;
                        s += pg8::bf_lo(qv[i].z) * kb.x; s += pg8::bf_hi(qv[i].z) * kb.y; s += pg8::bf_lo(qv[i].w) * kb.z; s += pg8::bf_hi(qv[i].w) * kb.w; }
                    if (s > v0) { v2 = v1; i2 = i1; v1 = v0; i1 = i0; v0 = s; i0 = n; } else if (s > v1) { v2 = v1; i2 = i1; v1 = s; i1 = n; } else if (s > v2) { v2 = s; i2 = n; } }
                unsigned mask = 1u << qb; if (i0 >= 0) mask |= 1u << i0; if (i1 >= 0) mask |= 1u << i1; if (i2 >= 0) mask |= 1u << i2;
                SEL[(size_t)(b * NH + h) * SEQ + t] = mask;
                __syncthreads(); } }
            { OpsPool O{(const char*)POOLED, (const char*)(ws + WS_WP + l * WP_L), 256, BW, 256};
              pg8::StaticOrder S; S.init(M, BW, G, bx);
              pg8::EpiPool E{BR + (size_t)2 * M * BW, BW, pool_scale + (size_t)l * BW, PROJ + C_G, N1};
              pg8::gemm_phase<pg8::EpiPool, pg8::StaticOrder, OpsPool, true, true>(lds, O, S, E); }
        }
        SEAM(pb + 3);

        if (PHEN(5) && IN(pb + 4)) {
#if ATTN_IN_KERNEL
#endif
        }
        SEAM(pb + 4);

        if (PHEN(6) && IN(pb + 5)) {
            OpsUp O{(const char*)BR, (const char*)(ws + WS_WB + l * WB_L), BW, BW, BW};
            pg8::StaticOrder S; S.init(4 * M, DM, G, bx);
            pg8::EpiStoreBf16 E{U, DM};
            pg8::gemm_phase<pg8::EpiStoreBf16, pg8::StaticOrder, OpsUp, true, true>(lds, O, S, E);
        }
        SEAM(pb + 5);

        if (PHEN(7) && IN(pb + 6)) {
            OpsMerge O{(const char*)HN, (const char*)(ws + WS_WG + l * WG_L), DM, DM, DM};
            pg8::QuadOrder S; S.base.init(M, DM, G, bx);
            pg8::EpiMerge E{MG, U, b_merge + (size_t)l * 4 * DM};
            pg8::gemm_phase<pg8::EpiMerge, pg8::QuadOrder, OpsMerge, true, true>(lds, O, S, E);
        }
        SEAM(pb + 6);

        if (PHEN(8) && IN(pb + 7)) {
            OpsPlain O{(const char*)MG, (const char*)(ws + WS_WO + l * WO_L), DM, DM, DM};
            pg8::StaticOrder S; S.init(M, DM, G, bx);
            pg8::EpiResid E{hin, out};
            pg8::gemm_phase<pg8::EpiResid, pg8::StaticOrder, OpsPlain, true, true>(lds, O, S, E);
        }
        SEAM(pb + 7);
    }

    if (PHEN(9) && IN(PH_FINAL)) { PHASE_IDS
        const f32x4* g4 = (const f32x4*)final_g;
        for (int row = gw; row < M; row += NGW) {
            f32x4* xr = (f32x4*)(out + (size_t)row * DM);
            f32x4 v[16]; float ss = 0.f;
#pragma unroll
            for (int j = 0; j < 16; ++j) { v[j] = xr[lane + 64 * j]; ss += (v[j].x * v[j].x + v[j].y * v[j].y) + (v[j].z * v[j].z + v[j].w * v[j].w); }
            const float rstd = 1.0f / sqrtf(wave_sum(ss) * (1.0f / DM) + RMS_EPS);
#pragma unroll
            for (int j = 0; j < 16; ++j) xr[lane + 64 * j] = v[j] * rstd * g4[lane + 64 * j];
        }
    }
#undef IN
#undef SEAM
}

__global__ void __launch_bounds__(256) naive_attn(const bf16* __restrict__ proj, int qcol, int kcol, int vcol, int gcol, const float* __restrict__ cvec, const unsigned* __restrict__ sel, bf16* __restrict__ outb, int mode) {
    __shared__ float sq[HD]; __shared__ float sc[SEQ]; __shared__ float red[256];
    const int idx = blockIdx.x, t = idx & (SEQ - 1), h = (idx >> 13) & 7, b = idx >> 16, tid = threadIdx.x;
    const size_t row = (size_t)b * SEQ + t;
    if (tid < HD) sq[tid] = bf2f(proj[row * N1 + qcol + h * HD + tid]);
    __syncthreads();
    const unsigned mask = mode == 0 ? sel[(size_t)(b * NH + h) * SEQ + t] : 0xffffffffu;
    const float ct = mode == 1 ? cvec[(size_t)(b * NH + h) * SEQ + t] : 0.f;
    const float NEG = -__builtin_inff(); float lmax = NEG;
    for (int j = tid; j <= t; j += 256) { float s = NEG;
        if ((mask >> (j >> 8)) & 1u) { const v4u* kr = (const v4u*)(proj + ((size_t)b * SEQ + j) * N1 + kcol + h * HD); float a = 0.f;
#pragma unroll 4
            for (int i = 0; i < 16; ++i) { const v4u w = kr[i]; const float* q = sq + 8 * i;
                a += q[0] * pg8::bf_lo(w.x) + q[1] * pg8::bf_hi(w.x) + q[2] * pg8::bf_lo(w.y) + q[3] * pg8::bf_hi(w.y) + q[4] * pg8::bf_lo(w.z) + q[5] * pg8::bf_hi(w.z) + q[6] * pg8::bf_lo(w.w) + q[7] * pg8::bf_hi(w.w); }
            s = a * 0.08838834764831845f; if (mode == 1) s += ct - cvec[(size_t)(b * NH + h) * SEQ + j]; }
        sc[j] = s; lmax = fmaxf(lmax, s); }
    red[tid] = lmax; __syncthreads();
    for (int o = 128; o > 0; o >>= 1) { if (tid < o) red[tid] = fmaxf(red[tid], red[tid + o]); __syncthreads(); }
    const float mx = red[0]; __syncthreads();
    float lsum = 0.f;
    for (int j = tid; j <= t; j += 256) { const float p = expf(sc[j] - mx); sc[j] = p; lsum += p; }
    red[tid] = lsum; __syncthreads();
    for (int o = 128; o > 0; o >>= 1) { if (tid < o) red[tid] += red[tid + o]; __syncthreads(); }
    const float tot = red[0]; __syncthreads();
    const int d = tid & 127, half = tid >> 7; float acc = 0.f;
    const bf16* vb = proj + (size_t)b * SEQ * N1 + vcol + h * HD + d;
    for (int j = half; j <= t; j += 2) { const float p = sc[j]; if (p != 0.f) acc += p * bf2f(vb[(size_t)j * N1]); }
    red[tid] = acc; __syncthreads();
    if (tid < 128) { const float o = (red[tid] + red[tid + 128]) / tot; const float g = bf2f(proj[row * N1 + gcol + h * HD + tid]);
        outb[row * BW + h * HD + tid] = (bf16)f2bf(o * siluf(g)); }
}

extern "C" void kernel_launch(void* const* d_in, const int* in_sizes, int n_in, void* d_out, int out_size, void* d_ws, size_t ws_size, hipStream_t stream) {
    static int grid = 0;
    if (grid == 0) {
        if (n_in != 11 || in_sizes[0] != M * DM || out_size != M * DM || ws_size < WS_END) { fprintf(stderr, "kernel_launch: unexpected shapes (n_in %d, in0 %d, out %d, ws %zu < %zu); nothing launched\n", n_in, n_in > 0 ? in_sizes[0] : -1, out_size, ws_size, (size_t)WS_END); grid = -1; return; }
        int dev = 0, cus = 0, per_cu = 0;
        if (hipGetDevice(&dev) != hipSuccess || hipDeviceGetAttribute(&cus, hipDeviceAttributeMultiprocessorCount, dev) != hipSuccess) { grid = -1; return; }
        if (hipFuncSetAttribute((const void*)fwd, hipFuncAttributeMaxDynamicSharedMemorySize, LDS_BYTES) != hipSuccess) { fprintf(stderr, "kernel_launch: hipFuncSetAttribute failed\n"); grid = -1; return; }
        if (hipOccupancyMaxActiveBlocksPerMultiprocessor(&per_cu, (const void*)fwd, NTHR, LDS_BYTES) != hipSuccess || per_cu < 1) fprintf(stderr, "kernel_launch: occupancy query reports %d\n", per_cu);
        (void)hipGetLastError();
        grid = cus;
    }
    if (grid < 0) return;
    (void)hipMemsetAsync((char*)d_ws + WS_CTL, 0, CTL_ZERO_BYTES, stream);
    Args a{};
    for (int i = 0; i < 11; ++i) a.in[i] = (const float*)d_in[i];
    a.out = (float*)d_out; a.ws = (unsigned char*)d_ws;
    unsigned char* ws = (unsigned char*)d_ws;
    const bf16* PROJ = (const bf16*)(ws + WS_PROJ); bf16* BR = (bf16*)(ws + WS_BR);
    for (int ph = 0; ph < N_PHASES; ++ph) {
        const bool attn = ph >= 1 && ph < PH_FINAL && ((ph - 1) % NPL) == 4;
        if (attn) {
            hipLaunchKernelGGL(naive_attn, dim3(BATCH * NH * SEQ), dim3(256), 0, stream, PROJ, A_Q, A_K, A_V, A_G, (const float*)nullptr, (const unsigned*)(ws + WS_SEL), BR, 0);
            hipLaunchKernelGGL(naive_attn, dim3(BATCH * NH * SEQ), dim3(256), 0, stream, PROJ, B_Q, B_K, B_V, B_G, (const float*)(ws + WS_C32), (const unsigned*)nullptr, BR + (size_t)M * BW, 1);
        } else {
            a.ph_lo = ph; a.ph_hi = ph + 1;
            hipLaunchKernelGGL(fwd, dim3(grid), dim3(NTHR), LDS_BYTES, stream, a);
        }
    }
}
```

```cpp
#include <hip/hip_runtime.h>
#include <cstdio>
#include <cstdint>

namespace pg8 {
#define PG8_LAS __attribute__((address_space(3)))
typedef unsigned short bf16_t;
typedef short bf16x8 __attribute__((ext_vector_type(8)));
typedef float f32x4 __attribute__((ext_vector_type(4)));
typedef unsigned u32x4 __attribute__((ext_vector_type(4)));
typedef int v4i_t __attribute__((ext_vector_type(4)));
typedef int v8i_t __attribute__((ext_vector_type(8)));
constexpr int BM = 256, BK = 64, HALF = 128, HTB = HALF * BK * 2  , STAGE_BYTES = 8 * HTB, NXCD = 8, WGM = 8;

__host__ __device__ __forceinline__ int lds_byte(int r, int c) { const int st = (r >> 4) * 2 + (c >> 5), rr = r & 15, cc = c & 31, ob = rr * 64 + cc * 2; return st * 1024 + (ob ^ (((ob >> 9) & 1) << 5)); }
__host__ __device__ __forceinline__ void stage_rc(int b, int& R, int& C) { const int st = b / 1024, sb = b % 1024, swz = sb ^ (((sb >> 9) & 1) << 5); R = (st >> 1) * 16 + swz / 64; C = (st & 1) * 32 + (swz % 64) / 2; }
__host__ __device__ __forceinline__ int perm32(int rho) { const int n = rho >> 4, i = rho & 15; return 8 * (i >> 2) + 4 * n + (i & 3); }

struct Unit { int pm, pn, z; };

struct StaticOrder {
    int nM, nN, nwg, G, c;
    __host__ __device__ void init(int M, int N, int G_, int c_) { nM = M / BM; nN = N / BM; nwg = nM * nN; G = G_; c = c_; }
    __host__ __device__ bool next(int i, Unit& u) const {
        const long L = (long)i * G + c; if (L >= nwg) return false;
        int wgid = (int)L; { const int q = nwg / NXCD, r = nwg % NXCD, xcd = wgid % NXCD, off = wgid / NXCD; wgid = (xcd < r ? xcd * (q + 1) : r * (q + 1) + (xcd - r) * q) + off; }
        const int nig = WGM * nN, gid = wgid / nig, fm = gid * WGM, gsz = (nM - fm) < WGM ? (nM - fm) : WGM;
        u.pm = fm + ((wgid % nig) % gsz); u.pn = (wgid % nig) / gsz; u.z = 0; return true;
    }
    __device__ __forceinline__ void a_ready(const Unit&) const {}
    __device__ __forceinline__ void done(const Unit&) const {}
};
struct QuadOrder {
    StaticOrder base;
    __host__ __device__ bool next(int i, Unit& u) const { if (!base.next(i >> 2, u)) return false; u.z = i & 3; return true; }
    __device__ __forceinline__ void a_ready(const Unit&) const {}
    __device__ __forceinline__ void done(const Unit&) const {}
};

__device__ __forceinline__ unsigned cvt_pk_bf16(float lo, float hi) { unsigned r; asm volatile("v_cvt_pk_bf16_f32 %0, %1, %2" : "=v"(r) : "v"(lo), "v"(hi)); return r; }
__device__ __forceinline__ float bf_lo(unsigned w) { return __uint_as_float(w << 16); }
__device__ __forceinline__ float bf_hi(unsigned w) { return __uint_as_float(w & 0xffff0000u); }
__device__ __forceinline__ float sigmoidf_fast(float x) { return __builtin_amdgcn_rcpf(1.0f + __builtin_amdgcn_exp2f(-1.4426950408889634f * x)); }

#ifndef F8_TILES
#define F8_TILES 0x0000000000000FFFull
#endif
constexpr unsigned long long F8T = F8_TILES;
constexpr int popc56(unsigned long long m) { int c = 0; for (int i = 0; i < 56; ++i) c += (int)((m >> i) & 1ull); return c; }
constexpr int NF8T = popc56(F8T), NBFT = 56 - NF8T;
static_assert(NF8T % 4 == 0 && (F8T & ~0x000000000FFF0FFFull) == 0ull, "fp8 tiles: whole rounds (multiples of 4), q|k|v tiles only");
__host__ __device__ __forceinline__ int nth_tile(int i, bool f8) { int c = 0; for (int t = 0; t < 56; ++t) { const bool is8 = (F8T >> t) & 1ull; if (is8 == f8) { if (c == i) return t; ++c; } } return 0; }
struct EpiStoreBf16 {
    static constexpr bool PERM = true, AFTER_DRAIN = false;
    bf16_t* O; int ldc; float asc;
    __device__ __forceinline__ void operator()(const f32x4 (&acc)[2][2][4][2], const Unit& u, int wr, int wc, int fr, int fq) const {
        const int row0 = u.pm * BM + wr * 64 + fr, col0 = u.pn * BM + wc * 32 + 8 * fq;
#pragma unroll
        for (int ai = 0; ai < 2; ++ai)
#pragma unroll
            for (int m = 0; m < 4; ++m) { bf16_t* rowp = O + (size_t)(row0 + ai * HALF + m * 16) * ldc + col0;
#pragma unroll
                for (int bj = 0; bj < 2; ++bj) { const f32x4 v0 = acc[ai][bj][m][0] * asc, v1 = acc[ai][bj][m][1] * asc;
                    u32x4 w; w.x = cvt_pk_bf16(v0[0], v0[1]); w.y = cvt_pk_bf16(v0[2], v0[3]); w.z = cvt_pk_bf16(v1[0], v1[1]); w.w = cvt_pk_bf16(v1[2], v1[3]);
                    *(u32x4*)(rowp + bj * HALF) = w; } }
    }
};
template <int MAP  > struct EpiProj {
    static constexpr bool PERM = true, AFTER_DRAIN = false;
    bf16_t* O; int ldc; float* ksum; unsigned* nrm; float asc;
    __device__ __forceinline__ void operator()(const f32x4 (&acc)[2][2][4][2], const Unit& u, int wr, int wc, int fr, int fq) const {
        const int ct = __builtin_amdgcn_readfirstlane(nth_tile(u.pn, MAP == 0));
        const int row0 = u.pm * BM + wr * 64 + fr, col0 = ct * BM + wc * 32 + 8 * fq;
#pragma unroll
        for (int ai = 0; ai < 2; ++ai)
#pragma unroll
            for (int m = 0; m < 4; ++m) { bf16_t* rowp = O + (size_t)(row0 + ai * HALF + m * 16) * ldc + col0;
#pragma unroll
                for (int bj = 0; bj < 2; ++bj) { const f32x4 v0 = acc[ai][bj][m][0] * asc, v1 = acc[ai][bj][m][1] * asc;
                    u32x4 w; w.x = cvt_pk_bf16(v0[0], v0[1]); w.y = cvt_pk_bf16(v0[2], v0[3]); w.z = cvt_pk_bf16(v1[0], v1[1]); w.w = cvt_pk_bf16(v1[2], v1[3]);
                    *(u32x4*)(rowp + bj * HALF) = w; } }
        const int pn = ct, bh0 = (u.pm >> 5) * 8;
        if (pn >= 4 && pn < 8) {
#pragma unroll
            for (int bj = 0; bj < 2; ++bj) { float cs[8];
#pragma unroll
                for (int j = 0; j < 8; ++j) { float a = 0.f;
#pragma unroll
                    for (int ai = 0; ai < 2; ++ai)
#pragma unroll
                        for (int m = 0; m < 4; ++m) a += acc[ai][bj][m][j >> 2][j & 3];
                    a += __shfl_xor(a, 1); a += __shfl_xor(a, 2); a += __shfl_xor(a, 4); a += __shfl_xor(a, 8); cs[j] = a * asc; }
                if (fr == 0) { float* dst = ksum + ((size_t)(bh0 + (pn - 4) * 2 + bj) * 32 + (u.pm & 31)) * 128 + wc * 32 + 8 * fq;
#pragma unroll
                    for (int j = 0; j < 8; ++j) atomicAdd(dst + j, cs[j]); } }
        } else if (pn >= 16 && pn < 24) {
#pragma unroll
            for (int bj = 0; bj < 2; ++bj) { float mx = 0.f;
#pragma unroll
                for (int ai = 0; ai < 2; ++ai)
#pragma unroll
                    for (int m = 0; m < 4; ++m) { const f32x4 a = acc[ai][bj][m][0], b = acc[ai][bj][m][1]; float ss = (a[0] * a[0] + a[1] * a[1]) + (a[2] * a[2] + a[3] * a[3]) + (b[0] * b[0] + b[1] * b[1]) + (b[2] * b[2] + b[3] * b[3]);
                        ss += __shfl_xor(ss, 16); ss += __shfl_xor(ss, 32); mx = fmaxf(mx, ss); }
                mx = fmaxf(mx, __shfl_xor(mx, 1)); mx = fmaxf(mx, __shfl_xor(mx, 2)); mx = fmaxf(mx, __shfl_xor(mx, 4)); mx = fmaxf(mx, __shfl_xor(mx, 8));
                if (fr == 0 && fq == 0) atomicMax(nrm + ((bh0 + (pn & 3) * 2 + bj) * 2 + (pn >= 20 ? 1 : 0)) * 4 + wc, __float_as_uint(mx * asc * asc * 1.02f)); }
        }
    }
};
struct EpiPool {
    static constexpr bool PERM = true, AFTER_DRAIN = false;
    bf16_t* O; int ldc; const float* pscale; const bf16_t* gate; int ldg;
    __device__ __forceinline__ void operator()(const f32x4 (&acc)[2][2][4][2], const Unit& u, int wr, int wc, int fr, int fq) const {
        const int row0 = u.pm * BM + wr * 64 + fr, col0 = u.pn * BM + wc * 32 + 8 * fq;
        f32x4 ps[2][2];
#pragma unroll
        for (int bj = 0; bj < 2; ++bj)
#pragma unroll
            for (int n = 0; n < 2; ++n) ps[bj][n] = *(const f32x4*)(pscale + col0 + bj * HALF + 4 * n);
#pragma unroll
        for (int ai = 0; ai < 2; ++ai)
#pragma unroll
            for (int m = 0; m < 4; ++m) { const size_t r = (size_t)(row0 + ai * HALF + m * 16);
#pragma unroll
                for (int bj = 0; bj < 2; ++bj) { const u32x4 g = *(const u32x4*)(gate + r * ldg + col0 + bj * HALF);
                    float gv[8] = {bf_lo(g.x), bf_hi(g.x), bf_lo(g.y), bf_hi(g.y), bf_lo(g.z), bf_hi(g.z), bf_lo(g.w), bf_hi(g.w)};
                    float o[8];
#pragma unroll
                    for (int j = 0; j < 8; ++j) { const float a = acc[ai][bj][m][j >> 2][j & 3] * ps[bj][j >> 2][j & 3]; o[j] = a * gv[j] * sigmoidf_fast(gv[j]); }
                    u32x4 w; w.x = cvt_pk_bf16(o[0], o[1]); w.y = cvt_pk_bf16(o[2], o[3]); w.z = cvt_pk_bf16(o[4], o[5]); w.w = cvt_pk_bf16(o[6], o[7]);
                    *(u32x4*)(O + r * ldc + col0 + bj * HALF) = w; }
                asm volatile("" ::: "memory"); }
    }
};
struct EpiMerge {
    static constexpr bool PERM = true, AFTER_DRAIN = false;
    bf16_t* P; const bf16_t* U; const float* bm; float asc;
    __device__ __forceinline__ void operator()(const f32x4 (&acc)[2][2][4][2], const Unit& u, int wr, int wc, int fr, int fq) const {
        const int row0 = u.pm * BM + wr * 64 + fr, col0 = u.pn * BM + wc * 32 + 8 * fq, z = u.z;
        const bf16_t* Uz = U + (size_t)z * 16384 * 4096;
        f32x4 bv[2][2];
#pragma unroll
        for (int bj = 0; bj < 2; ++bj)
#pragma unroll
            for (int n = 0; n < 2; ++n) bv[bj][n] = *(const f32x4*)(bm + z * 4096 + col0 + bj * HALF + 4 * n);
        u32x4 uu[3][2], pp[3][2];
#define EM_LOAD(g_, b_) do { const size_t off_ = (size_t)(row0 + ((g_) >> 2) * HALF + ((g_) & 3) * 16) * 4096 + col0; \
            uu[b_][0] = *(const u32x4*)(Uz + off_); uu[b_][1] = *(const u32x4*)(Uz + off_ + HALF); \
            if (z > 0) { pp[b_][0] = *(const u32x4*)(P + off_); pp[b_][1] = *(const u32x4*)(P + off_ + HALF); } else { pp[b_][0] = (u32x4){0u, 0u, 0u, 0u}; pp[b_][1] = (u32x4){0u, 0u, 0u, 0u}; } } while (0)
#define EM_DO(g_, b_) do { const int ai_ = (g_) >> 2, m_ = (g_) & 3; const size_t off = (size_t)(row0 + ai_ * HALF + m_ * 16) * 4096 + col0; \
            _Pragma("unroll") for (int bj = 0; bj < 2; ++bj) { const u32x4 ux = uu[b_][bj], px = pp[b_][bj]; \
                const float uv[8] = {bf_lo(ux.x), bf_hi(ux.x), bf_lo(ux.y), bf_hi(ux.y), bf_lo(ux.z), bf_hi(ux.z), bf_lo(ux.w), bf_hi(ux.w)}; \
                const float pv[8] = {bf_lo(px.x), bf_hi(px.x), bf_lo(px.y), bf_hi(px.y), bf_lo(px.z), bf_hi(px.z), bf_lo(px.w), bf_hi(px.w)}; \
                float o[8]; \
                _Pragma("unroll") for (int j = 0; j < 8; ++j) o[j] = pv[j] + sigmoidf_fast(acc[ai_][bj][m_][j >> 2][j & 3] * asc + bv[bj][j >> 2][j & 3]) * uv[j]; \
                u32x4 w; w.x = cvt_pk_bf16(o[0], o[1]); w.y = cvt_pk_bf16(o[2], o[3]); w.z = cvt_pk_bf16(o[4], o[5]); w.w = cvt_pk_bf16(o[6], o[7]); \
                *(u32x4*)(P + off + bj * HALF) = w; } } while (0)
        EM_LOAD(0, 0); EM_LOAD(1, 1); EM_LOAD(2, 2); asm volatile("" ::: "memory");
        EM_DO(0, 0); EM_DO(1, 1); EM_DO(2, 2); asm volatile("" ::: "memory");
        EM_LOAD(3, 0); EM_LOAD(4, 1); EM_LOAD(5, 2); asm volatile("" ::: "memory");
        EM_DO(3, 0); EM_DO(4, 1); EM_DO(5, 2); asm volatile("" ::: "memory");
        EM_LOAD(6, 0); EM_LOAD(7, 1); asm volatile("" ::: "memory");
        EM_DO(6, 0); EM_DO(7, 1); asm volatile("" ::: "memory");
#undef EM_DO
#undef EM_LOAD
    }
};
struct EpiResid {
    static constexpr bool PERM = true, AFTER_DRAIN = false;
    const float* hx; const bf16_t* hb; bf16_t* hout;
    __device__ __forceinline__ void operator()(const f32x4 (&acc)[2][2][4][2], const Unit& u, int wr, int wc, int fr, int fq) const {
        const int row0 = u.pm * BM + wr * 64 + fr, col0 = u.pn * BM + wc * 32 + 8 * fq;
        if (hx) {
            f32x4 hv[4][2][2];
#pragma unroll
            for (int ai = 0; ai < 2; ++ai) {
#pragma unroll
                for (int m = 0; m < 4; ++m) { const size_t off_ = (size_t)(row0 + ai * HALF + m * 16) * 4096 + col0;
                    hv[m][0][0] = *(const f32x4*)(hx + off_); hv[m][0][1] = *(const f32x4*)(hx + off_ + 4); hv[m][1][0] = *(const f32x4*)(hx + off_ + HALF); hv[m][1][1] = *(const f32x4*)(hx + off_ + HALF + 4); }
                asm volatile("" ::: "memory");
#pragma unroll
                for (int m = 0; m < 4; ++m) { const size_t off = (size_t)(row0 + ai * HALF + m * 16) * 4096 + col0;
#pragma unroll
                    for (int bj = 0; bj < 2; ++bj) { const f32x4 a = hv[m][bj][0] + acc[ai][bj][m][0], b = hv[m][bj][1] + acc[ai][bj][m][1];
                        u32x4 w; w.x = cvt_pk_bf16(a[0], a[1]); w.y = cvt_pk_bf16(a[2], a[3]); w.z = cvt_pk_bf16(b[0], b[1]); w.w = cvt_pk_bf16(b[2], b[3]); *(u32x4*)(hout + off + bj * HALF) = w; } }
                asm volatile("" ::: "memory"); }
        } else {
            u32x4 hv[8][2];
#pragma unroll
            for (int g = 0; g < 8; ++g) { const size_t off_ = (size_t)(row0 + (g >> 2) * HALF + (g & 3) * 16) * 4096 + col0; hv[g][0] = *(const u32x4*)(hb + off_); hv[g][1] = *(const u32x4*)(hb + off_ + HALF); }
            asm volatile("" ::: "memory");
#pragma unroll
            for (int g = 0; g < 8; ++g) { const int ai = g >> 2, m = g & 3; const size_t off = (size_t)(row0 + ai * HALF + m * 16) * 4096 + col0;
#pragma unroll
                for (int bj = 0; bj < 2; ++bj) { const u32x4 h = hv[g][bj]; const f32x4 a0 = acc[ai][bj][m][0], a1 = acc[ai][bj][m][1];
                    u32x4 w; w.x = cvt_pk_bf16(bf_lo(h.x) + a0[0], bf_hi(h.x) + a0[1]); w.y = cvt_pk_bf16(bf_lo(h.y) + a0[2], bf_hi(h.y) + a0[3]); w.z = cvt_pk_bf16(bf_lo(h.z) + a1[0], bf_hi(h.z) + a1[1]); w.w = cvt_pk_bf16(bf_lo(h.w) + a1[2], bf_hi(h.w) + a1[3]);
                    *(u32x4*)(hout + off + bj * HALF) = w; } }
        }
    }
};

template <class Epi, class Sched, class Ops, bool ALIGN_EPI, bool SP2, int FMT = 0  >
__device__ __forceinline__ void gemm_phase(PG8_LAS unsigned char* lds, const Ops& G, const Sched& S, const Epi& E) {
    int tid_ = threadIdx.x; asm volatile("" : "+v"(tid_));
    const int tid = tid_, wid = __builtin_amdgcn_readfirstlane(tid >> 6), lane = tid & 63, wr = wid >> 2, wc = wid & 3, fr = lane & 15, fq = lane >> 4;
    const int K = G.K, nt = K / BK;
    unsigned voffA[2], voffB[2];
#pragma unroll
    for (int i = 0; i < 2; ++i) { int R, C; stage_rc(tid * 16 + i * 8192, R, C); const int Rb = Epi::PERM ? ((R & ~31) + perm32(R & 31)) : R;
        voffA[i] = (unsigned)(R * G.lda + C) * 2u; voffB[i] = (unsigned)(Rb * G.ldb + C) * 2u; }
    const size_t kstep = (size_t)(BK * 2);
    const size_t hstepA = (size_t)HALF * G.lda * 2, hstepB = (size_t)HALF * G.ldb * 2;
    const unsigned ldsw = (unsigned)wid * 1024u;
    const int aoff = lds_byte(wr * 64 + fr, fq * 8), boff = lds_byte(wc * 32 + fr, fq * 8);
#define PG8_SA(b, h) (((b) * 2 + (h)) * HTB)
#define PG8_SB(b, h) ((4 + (b) * 2 + (h)) * HTB)
#define PG8_STAGE(bufoff, gbase, voff) do { _Pragma("unroll") for (int _i = 0; _i < 2; ++_i) \
        __builtin_amdgcn_global_load_lds((const unsigned*)((const char*)(gbase) + (voff)[_i]), (PG8_LAS unsigned*)(lds + (bufoff) + ldsw + _i * 8192), 16, 0, 0); } while (0)
#define PG8_LDA(dst, b, h) do { _Pragma("unroll") for (int m = 0; m < 4; ++m) { \
        if constexpr (FMT == 0) { _Pragma("unroll") for (int k = 0; k < 2; ++k) dst[m][k] = *(const PG8_LAS bf16x8*)(lds + PG8_SA(b, h) + aoff + m * 2048 + k * 1024); } \
        else { const v4i_t lo_ = *(const PG8_LAS v4i_t*)(lds + PG8_SA(b, h) + aoff + m * 2048), hi_ = *(const PG8_LAS v4i_t*)(lds + PG8_SA(b, h) + aoff + m * 2048 + 1024); dst##8[m] = __builtin_shufflevector(lo_, hi_, 0, 1, 2, 3, 4, 5, 6, 7); } } } while (0)
#define PG8_LDB(dst, b, h) do { _Pragma("unroll") for (int n = 0; n < 2; ++n) { \
        if constexpr (FMT == 0) { _Pragma("unroll") for (int k = 0; k < 2; ++k) dst[n][k] = *(const PG8_LAS bf16x8*)(lds + PG8_SB(b, h) + boff + n * 2048 + k * 1024); } \
        else { const v4i_t lo_ = *(const PG8_LAS v4i_t*)(lds + PG8_SB(b, h) + boff + n * 2048), hi_ = *(const PG8_LAS v4i_t*)(lds + PG8_SB(b, h) + boff + n * 2048 + 1024); dst##8[n] = __builtin_shufflevector(lo_, hi_, 0, 1, 2, 3, 4, 5, 6, 7); } } } while (0)
#define PG8_MMA(ai, bj, At, Bt) do { __builtin_amdgcn_s_setprio(1); _Pragma("unroll") for (int m = 0; m < 4; ++m) _Pragma("unroll") for (int n = 0; n < 2; ++n) { \
        if constexpr (FMT == 0) { _Pragma("unroll") for (int k = 0; k < 2; ++k) acc[ai][bj][m][n] = __builtin_amdgcn_mfma_f32_16x16x32_bf16(Bt[n][k], At[m][k], acc[ai][bj][m][n], 0, 0, 0); } \
        else {   \
            asm volatile("v_mfma_scale_f32_16x16x128_f8f6f4 %0, %1, %2, %0, %3, %3 op_sel_hi:[0,0,0]" : "+v"(acc[ai][bj][m][n]) : "v"(Bt##8[n]), "v"(At##8[m]), "v"(sc1_)); } }   \
        __builtin_amdgcn_s_setprio(0); } while (0)
#define PG8_WAIT_V(n) asm volatile("s_waitcnt vmcnt(" #n ")" ::: "memory")
#define PG8_WAIT_L(n) asm volatile("s_waitcnt lgkmcnt(" #n ")" ::: "memory")
#define PG8_BAR __builtin_amdgcn_s_barrier()
#define PG8_SCHED __builtin_amdgcn_sched_barrier(0)
    Unit cur, nxt; int ui = 0;
    if (!S.next(0, cur)) return;
    f32x4 acc[2][2][4][2];
#pragma unroll
    for (int a = 0; a < 2; ++a)
#pragma unroll
        for (int b = 0; b < 2; ++b)
#pragma unroll
            for (int m = 0; m < 4; ++m)
#pragma unroll
                for (int n = 0; n < 2; ++n) acc[a][b][m][n] = (f32x4){0.f, 0.f, 0.f, 0.f};
    bf16x8 At[4][2], B0[2][2], B1[2][2];
    const int sc1_ = 0x7f7f7f7f;
    v8i_t At8[4], B08[2], B18[2];
    (void)At; (void)B0; (void)B1; (void)At8; (void)B08; (void)B18; (void)sc1_;
    const char* cA = G.a_ptr(cur); const char* cB = G.b_ptr(cur);
    S.a_ready(cur);
    if constexpr (SP2) {
        PG8_STAGE(PG8_SB(0, 0), cB, voffB); PG8_STAGE(PG8_SB(0, 1), cB + hstepB, voffB); PG8_STAGE(PG8_SA(0, 0), cA, voffA); PG8_STAGE(PG8_SA(0, 1), cA + hstepA, voffA);
        if (wr == 1) PG8_BAR;
        PG8_WAIT_V(2); PG8_BAR;
        PG8_STAGE(PG8_SB(1, 0), cB + kstep, voffB); PG8_STAGE(PG8_SA(1, 0), cA + kstep, voffA); PG8_STAGE(PG8_SB(1, 1), cB + hstepB + kstep, voffB);
        PG8_WAIT_V(6); PG8_BAR;
    } else {
        PG8_STAGE(PG8_SB(0, 0), cB, voffB); PG8_STAGE(PG8_SA(0, 0), cA, voffA); PG8_STAGE(PG8_SB(0, 1), cB + hstepB, voffB); PG8_STAGE(PG8_SA(0, 1), cA + hstepA, voffA);
        if (wr == 1) PG8_BAR;
        PG8_WAIT_V(4); PG8_BAR;
        PG8_STAGE(PG8_SB(1, 0), cB + kstep, voffB); PG8_STAGE(PG8_SA(1, 0), cA + kstep, voffA); PG8_STAGE(PG8_SB(1, 1), cB + hstepB + kstep, voffB);
        PG8_WAIT_V(6); PG8_BAR;
    }
    for (;;) {
        const bool has_next = S.next(ui + 1, nxt);
        const char* nA = has_next ? G.a_ptr(nxt) : cA; const char* nB = has_next ? G.b_ptr(nxt) : cB;
        for (int t = 0; t < nt; t += 2) {
            const bool last = (t == nt - 2);
            const char* a1 = cA + (size_t)(t + 1) * kstep;
            const char* a2 = last ? nA : cA + (size_t)(t + 2) * kstep; const char* b2 = last ? nB : cB + (size_t)(t + 2) * kstep;
            const char* a3 = a2 + kstep; const char* b3 = b2 + kstep;
            if (last && has_next) S.a_ready(nxt);
            if constexpr (SP2) {
            PG8_LDB(B0, 0, 0); PG8_LDB(B1, 0, 1); PG8_SCHED; PG8_LDA(At, 0, 0); PG8_STAGE(PG8_SA(1, 1), a1 + hstepA, voffA);
            PG8_WAIT_V(8); PG8_WAIT_L(0); PG8_BAR; PG8_MMA(0, 0, At, B0); PG8_MMA(0, 1, At, B1); PG8_BAR; PG8_SCHED;
            PG8_LDA(At, 0, 1); PG8_STAGE(PG8_SB(0, 0), b2, voffB); PG8_STAGE(PG8_SB(0, 1), b2 + hstepB, voffB); PG8_STAGE(PG8_SA(0, 0), a2, voffA);
            PG8_WAIT_V(8); PG8_WAIT_L(0); PG8_BAR; PG8_MMA(1, 0, At, B0); PG8_MMA(1, 1, At, B1); PG8_BAR; PG8_SCHED;
            PG8_LDB(B0, 1, 0); PG8_LDB(B1, 1, 1); PG8_SCHED; PG8_LDA(At, 1, 0); PG8_STAGE(PG8_SA(0, 1), a2 + hstepA, voffA);
            PG8_WAIT_V(8); PG8_WAIT_L(0); PG8_BAR; PG8_MMA(0, 0, At, B0); PG8_MMA(0, 1, At, B1); PG8_BAR; PG8_SCHED;
            PG8_LDA(At, 1, 1); PG8_STAGE(PG8_SB(1, 0), b3, voffB); PG8_STAGE(PG8_SB(1, 1), b3 + hstepB, voffB); PG8_STAGE(PG8_SA(1, 0), a3, voffA);
            PG8_WAIT_V(8); PG8_WAIT_L(0); PG8_BAR; PG8_MMA(1, 0, At, B0); PG8_MMA(1, 1, At, B1); PG8_BAR; PG8_SCHED;
            } else {
            PG8_LDB(B0, 0, 0); PG8_SCHED; PG8_LDA(At, 0, 0); PG8_STAGE(PG8_SA(1, 1), a1 + hstepA, voffA);
            PG8_WAIT_L(8); PG8_BAR; PG8_WAIT_L(0); PG8_MMA(0, 0, At, B0); PG8_BAR; PG8_SCHED;
            PG8_LDB(B1, 0, 1); PG8_STAGE(PG8_SB(0, 0), b2, voffB);
            PG8_BAR; PG8_WAIT_L(0); PG8_MMA(0, 1, At, B1); PG8_BAR;
            PG8_LDA(At, 0, 1); PG8_STAGE(PG8_SA(0, 0), a2, voffA);
            PG8_BAR; PG8_WAIT_L(0); PG8_MMA(1, 0, At, B0); PG8_BAR; PG8_SCHED;
            PG8_STAGE(PG8_SB(0, 1), b2 + hstepB, voffB);
            PG8_WAIT_V(6); PG8_BAR; PG8_MMA(1, 1, At, B1); PG8_BAR;
            PG8_LDB(B0, 1, 0); PG8_SCHED; PG8_LDA(At, 1, 0); PG8_STAGE(PG8_SA(0, 1), a2 + hstepA, voffA);
            PG8_WAIT_L(8); PG8_BAR; PG8_WAIT_L(0); PG8_MMA(0, 0, At, B0); PG8_BAR; PG8_SCHED;
            PG8_LDB(B1, 1, 1); PG8_STAGE(PG8_SB(1, 0), b3, voffB);
            PG8_BAR; PG8_WAIT_L(0); PG8_MMA(0, 1, At, B1); PG8_BAR;
            PG8_LDA(At, 1, 1); PG8_STAGE(PG8_SA(1, 0), a3, voffA);
            PG8_BAR; PG8_WAIT_L(0); PG8_MMA(1, 0, At, B0); PG8_BAR; PG8_SCHED;
            PG8_STAGE(PG8_SB(1, 1), b3 + hstepB, voffB);
            PG8_WAIT_V(6); PG8_BAR; PG8_MMA(1, 1, At, B1); PG8_BAR;
            }
        }
        if constexpr (ALIGN_EPI) { if (wr == 0) PG8_BAR; }
        if constexpr (!Epi::AFTER_DRAIN) { E(acc, cur, wr, wc, fr, fq); S.done(cur); }
        if (!has_next) break;
#pragma unroll
        for (int a = 0; a < 2; ++a)
#pragma unroll
            for (int b = 0; b < 2; ++b)
#pragma unroll
                for (int m = 0; m < 4; ++m)
#pragma unroll
                    for (int n = 0; n < 2; ++n) acc[a][b][m][n] = (f32x4){0.f, 0.f, 0.f, 0.f};
        cur = nxt; cA = nA; cB = nB; ++ui;
        if constexpr (ALIGN_EPI) { if (wr == 1) PG8_BAR; }
    }
    PG8_WAIT_V(0);
    if constexpr (!ALIGN_EPI) { if (wr == 0) PG8_BAR; }
    PG8_BAR;
    if constexpr (Epi::AFTER_DRAIN) { E.fused(acc, cur, wr, wc, fr, fq, lds, wid, lane); S.done(cur); }
#undef PG8_SA
#undef PG8_SB
#undef PG8_STAGE
#undef PG8_LDA
#undef PG8_LDB
#undef PG8_MMA
#undef PG8_WAIT_V
#undef PG8_WAIT_L
#undef PG8_BAR
#undef PG8_SCHED
}
}
#define GAS __attribute__((address_space(1)))
#define LAS __attribute__((address_space(3)))
typedef unsigned short bf16;
typedef unsigned v4u __attribute__((ext_vector_type(4)));
typedef float f32x4 __attribute__((ext_vector_type(4)));
typedef short bf16x8 __attribute__((ext_vector_type(8)));
typedef GAS unsigned gu32;
typedef GAS unsigned long long gu64;
#define RLX_AGENT __ATOMIC_RELAXED, __HIP_MEMORY_SCOPE_AGENT
#define LDS_WAIT() asm volatile("s_waitcnt lgkmcnt(0)" ::: "memory")
#define VM_WAIT() asm volatile("s_waitcnt vmcnt(0)" ::: "memory")
__device__ __forceinline__ unsigned long long rt() { return __builtin_amdgcn_s_memrealtime(); }
__device__ __forceinline__ unsigned f2bf(float f) { unsigned u = __builtin_bit_cast(unsigned, f); return (u + 0x7fffu + ((u >> 16) & 1u)) >> 16; }
__device__ __forceinline__ unsigned pk2(float lo, float hi) { unsigned r; asm("v_cvt_pk_bf16_f32 %0, %1, %2" : "=v"(r) : "v"(lo), "v"(hi)); return r; }

#define XB_TMO      128
#define XB_XCNT(j)  (256  + 64 * (j))
#define XB_XSUB(j)  (1280 + 64 * (j))
#define XB_XGEN(j)  (2304 + 64 * (j))
#define XB_TOP      3328
#define XB_TOPGEN   3392
#define XCD_BAR_WORDS 3456
#define XB_SPIN_CAP (1u << 18)

__device__ __forceinline__ unsigned xb_ld(unsigned* p)              { return __hip_atomic_load(p, __ATOMIC_RELAXED, __HIP_MEMORY_SCOPE_AGENT); }
__device__ __forceinline__ unsigned xb_add(unsigned* p, unsigned v) { return __hip_atomic_fetch_add(p, v, __ATOMIC_RELAXED, __HIP_MEMORY_SCOPE_AGENT); }
__device__ __forceinline__ unsigned xb_xcc_id() { return (unsigned)__builtin_amdgcn_s_getreg((3 << 11) | 20) & 0xFu; }
#define XB_SPIN(cond, bar) do { unsigned _sp = 0; while (cond) { __builtin_amdgcn_s_sleep(1); \
    if ((++_sp & 255u) == 0u) { if (xb_ld(&(bar)[XB_TMO])) break; if (_sp > XB_SPIN_CAP) { atomicAdd(&(bar)[XB_TMO], 1u); break; } } } } while (0)

struct XcdBarrier {
    unsigned* bar; unsigned x;
    volatile LAS unsigned* st;
};

__device__ __forceinline__ XcdBarrier xcd_barrier_post(unsigned* bar, volatile LAS unsigned* st) {
    XcdBarrier b; b.bar = bar; b.x = xb_xcc_id(); b.st = st;
    if (threadIdx.x == 0) (void)xb_add(&bar[XB_XCNT(b.x)], 1u);
    return b;
}
__device__ __forceinline__ void xcd_barrier_complete(unsigned* bar, unsigned x, unsigned& nloc, unsigned& nx) {
    const unsigned G = gridDim.x * gridDim.y * gridDim.z;
    unsigned sum, cnt, mine, sp = 0u;
    for (;;) {
        sum = 0u; cnt = 0u; mine = 0u;
#pragma unroll
        for (unsigned j = 0; j < 16; ++j) { const unsigned c = xb_ld(&bar[XB_XCNT(j)]); sum += c; cnt += (c > 0u) ? 1u : 0u; mine = (j == x) ? c : mine; }
        if (sum == G) break;
        __builtin_amdgcn_s_sleep(1);
        if ((++sp & 255u) == 0u) { if (xb_ld(&bar[XB_TMO])) break; if (sp > XB_SPIN_CAP) { atomicAdd(&bar[XB_TMO], 1u); break; } }
    }
    nloc = mine > 0u ? mine : 1u; nx = cnt > 0u ? cnt : 1u;
}

__device__ __forceinline__ void xcd_barrier(const XcdBarrier& b) {
    asm volatile("s_waitcnt vmcnt(0)" ::: "memory");
    __syncthreads();
    if (threadIdx.x == 0) {
        unsigned* bar = b.bar;
        __builtin_amdgcn_s_waitcnt(0);
        unsigned nloc = b.st[0], nx = b.st[1];
        if (nloc == 0u) { xcd_barrier_complete(bar, b.x, nloc, nx); b.st[0] = nloc; b.st[1] = nx; }
        const unsigned old = xb_add(&bar[XB_XSUB(b.x)], 1u);
        const unsigned gen = old / nloc;
        if (old + 1u == (gen + 1u) * nloc) {
            __builtin_amdgcn_fence(__ATOMIC_RELEASE, "agent");
            asm volatile("s_waitcnt vmcnt(0)" ::: "memory");
            const unsigned og = xb_add(&bar[XB_TOP], 1u);
            const unsigned tg = og / nx;
            if (og + 1u == (tg + 1u) * nx) xb_add(&bar[XB_TOPGEN], 1u);
            else XB_SPIN(xb_ld(&bar[XB_TOPGEN]) == tg, bar);
            __builtin_amdgcn_fence(__ATOMIC_ACQUIRE, "agent");
            xb_add(&bar[XB_XGEN(b.x)], 1u);
            asm volatile("s_waitcnt vmcnt(0)" ::: "memory");
        } else {
            XB_SPIN(xb_ld(&bar[XB_XGEN(b.x)]) == gen, bar);
            __builtin_amdgcn_fence(__ATOMIC_ACQUIRE, "agent");
            asm volatile("s_waitcnt vmcnt(0)" ::: "memory");
        }
    }
    __syncthreads();
}

#ifndef DIAG_MOBA
#define DIAG_MOBA 0
#endif
#ifndef DIAG_TOL
#define DIAG_TOL 0.03f
#endif
#ifndef DIAG_MAXBAD
#define DIAG_MAXBAD 2000u
#endif
namespace att {
typedef short s16x4 __attribute__((ext_vector_type(4)));
typedef float f32x16 __attribute__((ext_vector_type(16)));
typedef unsigned u32x4 __attribute__((ext_vector_type(4)));
constexpr int D = 128, NW = 8, QBLK = 32, KVBLK = 64, QB = NW * QBLK;
constexpr int SHM_V = KVBLK * D * 2, SHM_K = KVBLK * D * 2;
constexpr int OFF_K = 2 * SHM_V, OFF_WS = 2 * SHM_V + 2 * SHM_K, OFF_BIAS = OFF_WS + NW * 96 * 4, LDS_ATT = OFF_BIAS + 2 * 1024;
constexpr float SCALE = 0.08838834764831845f, THR = 8.f;
constexpr int LDI = 14336, LDO = 1024;
#define KSWZ(row, colB) ((row) * 256 + ((colB) ^ (((row) & 7) << 4)))
#define SBAR() __builtin_amdgcn_sched_barrier(0)
__device__ __forceinline__ int v_st(int k, int c) { const int kk = (k & ~0xC) | ((k & 4) << 1) | ((k & 8) >> 1); return ((kk >> 3) * 4 + (c >> 5)) * 512 + ((kk & 7) * 32 + (c & 31)) * 2; }
__device__ __forceinline__ int v_rd_base(int lane) { return ((lane & 3) << 3) | (((lane >> 2) & 3) << 6) | (((lane >> 4) & 1) << 5) | (((lane >> 5) & 1) << 8); }
constexpr int v_rd_off(int d0, int ks, int half) { return d0 * 512 + ks * 4096 + half * 2048; }
__device__ __forceinline__ int crow(int r, int hi) { return (r & 3) + 8 * (r >> 2) + 4 * hi; }
__device__ __forceinline__ unsigned cvtpk(float lo, float hi) { unsigned r; asm volatile("v_cvt_pk_bf16_f32 %0, %1, %2" : "=v"(r) : "v"(lo), "v"(hi)); return r; }
__device__ __forceinline__ bf16x8 load8(const bf16* p) { return *reinterpret_cast<const bf16x8*>(p); }
__device__ __forceinline__ void mask_tile(f32x16& p0, f32x16& p1, int dq) {
    const float NEG = -__builtin_inff();
#pragma unroll
    for (int r = 0; r < 16; ++r) { const int c = (r & 3) + 8 * (r >> 2); if (dq - c < 0) p0[r] = NEG; if (dq - c - 32 < 0) p1[r] = NEG; }
}
template <bool DEFER>
__device__ __forceinline__ void partialSM(f32x16& p0, f32x16& p1, float& m_reg, float& mn, float& alpha) {
    float pmax = p0[0]; for (int r = 1; r < 16; ++r) pmax = fmaxf(pmax, p0[r]); for (int r = 0; r < 16; ++r) pmax = fmaxf(pmax, p1[r]);
    { auto rr = __builtin_amdgcn_permlane32_swap(__float_as_uint(pmax), __float_as_uint(pmax), false, false);
      pmax = fmaxf(__uint_as_float(rr[0]), __uint_as_float(rr[1])); }
    constexpr float C2 = 1.4426950408889634f * SCALE;
    if (DEFER && __builtin_expect(__all((pmax - m_reg) * SCALE <= THR), 1)) { mn = m_reg; alpha = 1.f; }
    else { mn = fmaxf(m_reg, pmax); alpha = __builtin_amdgcn_exp2f((m_reg - mn) * C2); m_reg = mn; }
    const float mnL = -mn * C2;
    for (int r = 0; r < 16; ++r) p0[r] = fmaf(p0[r], C2, mnL); for (int r = 0; r < 16; ++r) p1[r] = fmaf(p1[r], C2, mnL);
    for (int r = 0; r < 16; ++r) p0[r] = __builtin_amdgcn_exp2f(p0[r]);
}
__device__ __forceinline__ void finishSM(f32x16& p0, f32x16& p1, float alpha, float& l_reg, bf16x8& pa0, bf16x8& pa1, bf16x8& pa2, bf16x8& pa3) {
    for (int r = 0; r < 16; ++r) p1[r] = __builtin_amdgcn_exp2f(p1[r]);
    float ps = 0; for (int r = 0; r < 16; ++r) ps += p0[r]; for (int r = 0; r < 16; ++r) ps += p1[r];
    { auto rr = __builtin_amdgcn_permlane32_swap(__float_as_uint(ps), __float_as_uint(ps), false, false);
      ps = __uint_as_float(rr[0]) + __uint_as_float(rr[1]); }
    l_reg = l_reg * alpha + ps;
#define PK4(P, B_, OUT) do { unsigned a0 = cvtpk(P[B_+0], P[B_+1]), a1 = cvtpk(P[B_+2], P[B_+3]);                          \
        unsigned b0 = cvtpk(P[B_+4], P[B_+5]), b1 = cvtpk(P[B_+6], P[B_+7]);                                             \
        auto r0 = __builtin_amdgcn_permlane32_swap(a0, b0, false, false); auto r1 = __builtin_amdgcn_permlane32_swap(a1, b1, false, false); \
        u32x4 w = {r0[0], r1[0], r0[1], r1[1]}; OUT = *reinterpret_cast<bf16x8*>(&w); } while (0)
    PK4(p0, 0, pa0); PK4(p0, 8, pa1); PK4(p1, 0, pa2); PK4(p1, 8, pa3);
#undef PK4
}
template <int KB, int MODE>
__device__ __forceinline__ void qkt(f32x16& p0, f32x16& p1, const char* K_lds, const char* B_lds, int r32, int hi, const bf16x8* qr) {
    p0 = f32x16{}; p1 = f32x16{};
    const char* kb[4];
#pragma unroll
    for (int dd = 0; dd < 4; ++dd) kb[dd] = K_lds + KB * SHM_K + KSWZ(r32, (dd * 16 + hi * 8) * 2);
#pragma unroll
    for (int d0 = 0; d0 < 8; ++d0) { const char* a = kb[d0 & 3] + (d0 >> 2) * 128;
        bf16x8 b0 = *reinterpret_cast<const bf16x8*>(a);
        bf16x8 b1 = *reinterpret_cast<const bf16x8*>(a + 32 * 256);
        p0 = __builtin_amdgcn_mfma_f32_32x32x16_bf16(b0, qr[d0], p0, 0, 0, 0);
        p1 = __builtin_amdgcn_mfma_f32_32x32x16_bf16(b1, qr[d0], p1, 0, 0, 0); }
    if (MODE == 1) { const unsigned one2 = hi ? 0u : 0x3f803f80u, one1 = hi ? 0u : 0x00003f80u; const u32x4 qw = {one2, one1, 0u, 0u}; const bf16x8 qx = *reinterpret_cast<const bf16x8*>(&qw);
        const bf16x8 e0 = *reinterpret_cast<const bf16x8*>(B_lds + KB * 1024 + r32 * 16), e1 = *reinterpret_cast<const bf16x8*>(B_lds + KB * 1024 + 512 + r32 * 16);
        p0 = __builtin_amdgcn_mfma_f32_32x32x16_bf16(e0, qx, p0, 0, 0, 0);
        p1 = __builtin_amdgcn_mfma_f32_32x32x16_bf16(e1, qx, p1, 0, 0, 0); }
}
template <int VB>
__device__ __forceinline__ void pv_tile(f32x16* o, int vb0, bf16x8 pa0, bf16x8 pa1, bf16x8 pa2, bf16x8 pa3) {
#define TRRD(dst, off) asm volatile("ds_read_b64_tr_b16 %0, %1 offset:%2" : "=&v"(dst) : "v"(vb0), "i"(off) : "memory")
#define PV_D0(d0) do { s16x4 l0, l1, l2, l3, h0, h1, h2, h3; constexpr int b_ = VB * SHM_V + v_rd_off(d0, 0, 0); \
        TRRD(l0, b_); TRRD(h0, b_ + 2048); TRRD(l1, b_ + 4096); TRRD(h1, b_ + 6144); TRRD(l2, b_ + 8192); TRRD(h2, b_ + 10240); TRRD(l3, b_ + 12288); TRRD(h3, b_ + 14336); \
        asm volatile("s_waitcnt lgkmcnt(0)" ::: "memory"); SBAR(); \
        o[d0] = __builtin_amdgcn_mfma_f32_32x32x16_bf16(pa0, (bf16x8){l0[0], l0[1], l0[2], l0[3], h0[0], h0[1], h0[2], h0[3]}, o[d0], 0, 0, 0);   \
        o[d0] = __builtin_amdgcn_mfma_f32_32x32x16_bf16(pa1, (bf16x8){l1[0], l1[1], l1[2], l1[3], h1[0], h1[1], h1[2], h1[3]}, o[d0], 0, 0, 0);   \
        o[d0] = __builtin_amdgcn_mfma_f32_32x32x16_bf16(pa2, (bf16x8){l2[0], l2[1], l2[2], l2[3], h2[0], h2[1], h2[2], h2[3]}, o[d0], 0, 0, 0);   \
        o[d0] = __builtin_amdgcn_mfma_f32_32x32x16_bf16(pa3, (bf16x8){l3[0], l3[1], l3[2], l3[3], h3[0], h3[1], h3[2], h3[3]}, o[d0], 0, 0, 0); } while (0)
    PV_D0(0); PV_D0(1); PV_D0(2); PV_D0(3);
#undef PV_D0
#undef TRRD
}

struct Bases { const bf16* proj; bf16* br; const v4u* bias; const unsigned* sel; const unsigned* lists; bf16* part; float* ml; };
struct BlockRef { int bh, qb, j0, kind, lbase, nval; };
template <int MODE> struct Ptrs {
    static __device__ __forceinline__ const bf16* hb(const Bases& B, const BlockRef& R) { return B.proj + (size_t)((unsigned)(R.bh >> 3) * 8192u) * LDI + (unsigned)((R.bh & 7) * 128 + (MODE == 1 ? 4096 : 0)); }
    static __device__ __forceinline__ const bf16* Q(const Bases& B, const BlockRef& R) { return hb(B, R) + (size_t)((unsigned)R.qb * 256u) * LDI; }
    static __device__ __forceinline__ const bf16* K(const Bases& B, const BlockRef& R) { return hb(B, R) + 1024; }
    static __device__ __forceinline__ const bf16* V(const Bases& B, const BlockRef& R) { return hb(B, R) + 2048; }
    static __device__ __forceinline__ const bf16* Gt(const Bases& B, const BlockRef& R) { return hb(B, R) + (size_t)((unsigned)R.qb * 256u) * LDI + 3072; }
    static __device__ __forceinline__ bf16* O(const Bases& B, const BlockRef& R) { return B.br + ((size_t)(MODE == 1 ? 1 : 0) * 16384 + (size_t)((unsigned)(R.bh >> 3) * 8192u + (unsigned)R.qb * 256u)) * LDO + (unsigned)((R.bh & 7) * 128); }
    static __device__ __forceinline__ const v4u* Bias(const Bases& B, const BlockRef& R) { return B.bias + (size_t)((unsigned)R.bh * 8192u); }
    static __device__ __forceinline__ const unsigned* Sel(const Bases& B, const BlockRef& R) { return B.sel + (size_t)((unsigned)R.bh * 8192u + (unsigned)R.qb * 256u); }
};
struct Seam { bf16x8 qr[8]; bf16x8 st_v0, st_v1, st_k0, st_k1; v4u st_b; unsigned selr; };
#define ROW(p, k0, rr) ((p) + (size_t)(((unsigned)(k0) + (unsigned)(rr)) * (unsigned)LDI + (unsigned)sc))
#define VMW() asm volatile("s_waitcnt vmcnt(0)" ::: "memory")
#define VMWN(n) asm volatile("s_waitcnt vmcnt(%0)" :: "i"(n) : "memory")
#define SLOAD_H(R_, k0) do { const bf16* Vp_ = Ptrs<MODE>::V(BS, R_); const bf16* Kp_ = Ptrs<MODE>::K(BS, R_); S.st_v0 = load8(ROW(Vp_, k0, sr)); S.st_v1 = load8(ROW(Vp_, k0, 32 + sr));              \
                         S.st_k0 = load8(ROW(Kp_, k0, sr)); S.st_k1 = load8(ROW(Kp_, k0, 32 + sr)); if (MODE == 1 && tid < 64) S.st_b = Ptrs<MODE>::Bias(BS, R_)[(unsigned)(k0) + (unsigned)tid]; } while (0)
#define SWRITE_HK(bf) do { *(bf16x8*)(K_lds + (bf) * SHM_K + kws) = S.st_k0; *(bf16x8*)(K_lds + (bf) * SHM_K + kws + 32 * 256) = S.st_k1; if (MODE == 1 && tid < 64) *(v4u*)(B_lds + (bf) * 1024 + tid * 16) = S.st_b; } while (0)
#define SWRITE_HV(bf) do { *(bf16x8*)(V_lds + (bf) * SHM_V + vst0) = S.st_v0; *(bf16x8*)(V_lds + (bf) * SHM_V + vst1) = S.st_v1; } while (0)
#define SWRITE_H(bf) do { SWRITE_HV(bf); SWRITE_HK(bf); } while (0)
__device__ __forceinline__ unsigned row_entry(const Bases& B, const BlockRef& R, int i) {
    if (R.kind == 0) return (unsigned)(R.qb * 256 + i) | (3u << 16) | 0x80000000u;
    const bool v = i < R.nval; return B.lists[(unsigned)R.lbase + (unsigned)(v ? i : 0)] | (v ? 0x80000000u : 0u);
}
template <int MODE>
__device__ __forceinline__ void attn_prime(const Bases& BS, const BlockRef& cur, char* lds, Seam& S) {
    int tid_ = threadIdx.x; asm volatile("" : "+v"(tid_));
    const int tid = tid_, wid = __builtin_amdgcn_readfirstlane(tid >> 6), lane = tid & 63, r32 = lane & 31, hi = lane >> 5;
    const int sr = tid >> 4, sc = (tid & 15) * 8, kws = KSWZ(sr, sc * 2); char* K_lds = lds + OFF_K; char* B_lds = lds + OFF_BIAS;
    if (MODE == 2) { S.selr = row_entry(BS, cur, wid * QBLK + r32); const bf16* qrow = Ptrs<MODE>::hb(BS, cur) + (size_t)((S.selr & 0xffffu) * (unsigned)LDI);
#pragma unroll
        for (int d0 = 0; d0 < 8; ++d0) S.qr[d0] = load8(qrow + (unsigned)(d0 * 16 + hi * 8)); }
    else {
#pragma unroll
    for (int d0 = 0; d0 < 8; ++d0) S.qr[d0] = load8(Ptrs<MODE>::Q(BS, cur) + (size_t)((unsigned)(wid * QBLK + r32) * (unsigned)LDI + (unsigned)(d0 * 16 + hi * 8)));
    if (MODE == 0) S.selr = Ptrs<MODE>::Sel(BS, cur)[(unsigned)(wid * QBLK + r32)]; }
    SLOAD_H(cur, cur.j0 * KVBLK); VMW(); SWRITE_HK(0);
    __syncthreads();
}
template <int MODE>
__device__ __forceinline__ void attn_block(const Bases& BS, const BlockRef& cur, const BlockRef& nxt, char* lds, Seam& S) {
    int tid_ = threadIdx.x; asm volatile("" : "+v"(tid_));
    const int tid = tid_, wid = __builtin_amdgcn_readfirstlane(tid >> 6), lane = tid & 63, r32 = lane & 31, hi = lane >> 5;
    const int P0 = cur.qb * QB, j0 = cur.j0, NT = (MODE == 2) ? 4 : (P0 + QB - 1) / KVBLK + 1 - j0;
    const int qlo = P0 + wid * QBLK, qm = qlo + r32 - 4 * hi;
    char* V_lds = lds; char* K_lds = lds + OFF_K; char* B_lds = lds + OFF_BIAS;
    float* ws = (float*)(lds + OFF_WS) + wid * 96; float* li_l = ws, * al_l = ws + 32;
    float m_reg = -1e30f, l_reg = 0; f32x16 o[4] = {};
    const int sr = tid >> 4, sc = (tid & 15) * 8, vst0 = v_st(sr, sc), vst1 = v_st(32 + sr, sc), kws = KSWZ(sr, sc * 2);
    const int vb0 = (int)(uintptr_t)V_lds + v_rd_base(lane);
    const unsigned selr = S.selr;
    unsigned* rowtab = (unsigned*)ws + 64;
    unsigned entn = 0u; if (MODE == 2) { if (hi == 0) rowtab[r32] = selr; entn = row_entry(BS, nxt, wid * QBLK + r32); }
#define RESC(a) do { if (__any((a) < 1.f)) { if (hi == 0) al_l[r32] = (a); asm volatile("s_waitcnt lgkmcnt(0)" ::: "memory");              \
                     for (int d_ = 0; d_ < 4; ++d_) for (int r = 0; r < 16; ++r) o[d_][r] *= al_l[crow(r, hi)]; } } while (0)
#define KBASE(t) ((j0 + (t)) * KVBLK)
#define MASKT(P0_, P1_, t) do { const int kb_ = KBASE(t); if ((MODE != 2 || cur.kind == 0) && kb_ + KVBLK - 1 > qlo) mask_tile(P0_, P1_, qm - kb_); \
        if (MODE == 0) { const bool keep_ = (selr >> (kb_ >> 8)) & 1u; if (!__all(keep_)) { const float NEG_ = -__builtin_inff(); \
            _Pragma("unroll") for (int r = 0; r < 16; ++r) { P0_[r] = keep_ ? P0_[r] : NEG_; P1_[r] = keep_ ? P1_[r] : NEG_; } } } } while (0)
    constexpr int NQL = 8 + (MODE == 0 ? 1 : 0);
#define SEAM_K0() do { VMWN(NQL); SWRITE_HK(0); SBAR(); } while (0)
    f32x16 pA0, pA1, pB0, pB1; float mnA, mnB, alA, alB; bf16x8 pa0, pa1, pa2, pa3;
    SWRITE_HV(0); SBAR();
    if (NT > 1) SLOAD_H(cur, KBASE(1));
    SBAR(); qkt<0, MODE>(pA0, pA1, K_lds, B_lds, r32, hi, S.qr);
    MASKT(pA0, pA1, 0); partialSM<MODE != 2>(pA0, pA1, m_reg, mnA, alA);
    if (NT > 1) { VMW(); SWRITE_H(1); }
    __syncthreads();
#define HALF_STEP(PX0, PX1, mnX, alX, PY0, PY1, alY, t, KB, VB, SB) do {                                                      \
        SBAR(); qkt<KB, MODE>(PX0, PX1, K_lds, B_lds, r32, hi, S.qr);                                             \
        finishSM(PY0, PY1, alY, l_reg, pa0, pa1, pa2, pa3); SBAR();                                                           \
        if ((t) + 1 < NT) { SLOAD_H(cur, KBASE((t) + 1)); SBAR(); }                                               \
        pv_tile<VB>(o, vb0, pa0, pa1, pa2, pa3); MASKT(PX0, PX1, (t)); partialSM<MODE != 2>(PX0, PX1, m_reg, mnX, alX);                                        \
        __syncthreads();                                                                                                      \
        if ((t) + 1 < NT) { VMW(); SWRITE_H(SB); }                                                                          \
        RESC(alX); __syncthreads(); } while (0)
    for (int t = 1; t + 1 < NT; t += 2) {
        HALF_STEP(pB0, pB1, mnB, alB, pA0, pA1, alA, t, 1, 0, 0);
        HALF_STEP(pA0, pA1, mnA, alA, pB0, pB1, alB, t + 1, 0, 1, 1);
    }
    SBAR(); qkt<1, MODE>(pB0, pB1, K_lds, B_lds, r32, hi, S.qr); SBAR();
    SLOAD_H(nxt, nxt.j0 * KVBLK); SBAR();
    if (MODE == 2) { const bf16* qrow = Ptrs<MODE>::hb(BS, nxt) + (size_t)((entn & 0xffffu) * (unsigned)LDI);
#pragma unroll
        for (int d0 = 0; d0 < 8; ++d0) S.qr[d0] = load8(qrow + (unsigned)(d0 * 16 + hi * 8));
        S.selr = entn; }
    else {
#pragma unroll
    for (int d0 = 0; d0 < 8; ++d0) S.qr[d0] = load8(Ptrs<MODE>::Q(BS, nxt) + (size_t)((unsigned)(wid * QBLK + r32) * (unsigned)LDI + (unsigned)(d0 * 16 + hi * 8)));
    if (MODE == 0) S.selr = Ptrs<MODE>::Sel(BS, nxt)[(unsigned)(wid * QBLK + r32)]; }
    SBAR();
    finishSM(pA0, pA1, alA, l_reg, pa0, pa1, pa2, pa3); SBAR();
    pv_tile<0>(o, vb0, pa0, pa1, pa2, pa3);
    MASKT(pB0, pB1, NT - 1); partialSM<MODE != 2>(pB0, pB1, m_reg, mnB, alB); __syncthreads(); RESC(alB);
    finishSM(pB0, pB1, alB, l_reg, pa0, pa1, pa2, pa3); SBAR(); pv_tile<1>(o, vb0, pa0, pa1, pa2, pa3);
    SBAR(); SEAM_K0();
    if (hi == 0) li_l[r32] = l_reg; asm volatile("s_waitcnt lgkmcnt(0)" ::: "memory");
    float rli[16];
#pragma unroll
    for (int r = 0; r < 16; ++r) rli[r] = __builtin_amdgcn_rcpf(li_l[crow(r, hi)]);
    if (MODE == 2) {
        if (hi == 0 && (selr >> 31)) { float* mlp = BS.ml + (((size_t)((unsigned)cur.bh * 8192u + (selr & 0xffffu))) * 4 + ((selr >> 16) & 3u)) * 2; mlp[0] = m_reg; mlp[1] = l_reg; }
#pragma unroll
        for (int r = 0; r < 16; ++r) { const unsigned re = rowtab[crow(r, hi)]; bf16* prow = BS.part + (((size_t)((unsigned)cur.bh * 8192u + (re & 0xffffu))) * 4 + ((re >> 16) & 3u)) * 128 + (unsigned)r32; const bool st = (r32 & 1) == 0 && (re >> 31);
#pragma unroll
            for (int d0 = 0; d0 < 4; ++d0) { const float v = o[d0][r] * rli[r]; const float vn = __shfl_xor(v, 1); if (st) *(unsigned*)(prow + d0 * 32) = cvtpk(v, vn); } }
        __syncthreads(); return; }
    bf16* Ow = Ptrs<MODE>::O(BS, cur) + (size_t)((unsigned)(wid * QBLK) * (unsigned)LDO); const bf16* Gw = Ptrs<MODE>::Gt(BS, cur) + (size_t)((unsigned)(wid * QBLK) * (unsigned)LDI);
#pragma unroll
    for (int d0 = 0; d0 < 4; ++d0) {
        unsigned gp[16];
        if ((r32 & 1) == 0) {
#pragma unroll
            for (int r = 0; r < 16; ++r) gp[r] = *(const unsigned*)(Gw + (size_t)((unsigned)crow(r, hi) * (unsigned)LDI + (unsigned)(d0 * 32 + r32))); }
#pragma unroll
        for (int r = 0; r < 16; ++r) { const float v = o[d0][r] * rli[r]; const float vn = __shfl_xor(v, 1);
            if ((r32 & 1) == 0) { const float g0 = pg8::bf_lo(gp[r]), g1 = pg8::bf_hi(gp[r]);
                *(unsigned*)(Ow + (size_t)((unsigned)crow(r, hi) * (unsigned)LDO + (unsigned)(d0 * 32 + r32))) = cvtpk(v * g0 * pg8::sigmoidf_fast(g0), vn * g1 * pg8::sigmoidf_fast(g1)); } }
    }
    __syncthreads();
#undef RESC
#undef KBASE
#undef MASKT
#undef SEAM_K0
#undef HALF_STEP
}
#undef ROW
#undef VMW
#undef VMWN
#undef SLOAD_H
#undef SWRITE_HK
#undef SWRITE_HV
#undef SWRITE_H
#undef KSWZ
}

constexpr int BATCH = 2, SEQ = 8192, DM = 4096, M = BATCH * SEQ, NIN = 30728, BW = 1024, NH = 8, HD = 128, NBLK = SEQ / 256, DEPTH = 2;
constexpr int N1 = 14336;
constexpr int A_Q = 0, A_K = 1024, A_V = 2048, A_G = 3072, B_Q = 4096, B_K = 5120, B_V = 6144, B_G = 7168, C_IN = 8192, C_G = 9216, D_B = 10240, D_C = 11264, D_X = 12288, D_G = 13312;
constexpr int SRC_FORGET = 8192, SRC_SEG2 = 8200, SRC_MERGE = 14344;
constexpr float RMS_EPS = 1e-6f;
constexpr int NWAVES = 8, NTHR = 512;

constexpr size_t MiB = 1ull << 20;
constexpr size_t WS_CTL = 0, CTL_ZERO_BYTES = 1 * MiB;
constexpr size_t W1T_L = (size_t)N1 * DM * 2, WG_L = (size_t)4 * DM * DM * 2, WB_L = (size_t)4 * DM * BW * 2, WO_L = (size_t)DM * DM * 2, WP_L = (size_t)4 * 256 * 256 * 2;
constexpr size_t WS_W1T = 1 * MiB;
constexpr size_t WS_WG = WS_W1T + 2 * W1T_L;
constexpr size_t WS_WB = WS_WG + 2 * WG_L;
constexpr size_t WS_WO = WS_WB + 2 * WB_L;
constexpr size_t WS_WP = WS_WO + 2 * WO_L;
constexpr size_t WS_HN = WS_WP + 2 * WP_L;
constexpr size_t WS_PROJ = WS_HN + (size_t)M * DM * 2;
constexpr size_t WS_BR = WS_PROJ + (size_t)M * N1 * 2;
constexpr size_t WS_U = WS_BR + (size_t)4 * M * BW * 2;
constexpr size_t WS_MG = WS_U + (size_t)4 * M * DM * 2;
constexpr size_t WS_POOLED = WS_MG + (size_t)M * DM * 2;
constexpr size_t WS_LF = WS_POOLED + (size_t)M * BW * 2;
constexpr size_t WS_C32 = WS_LF + MiB;
constexpr size_t WS_BIAS = WS_C32 + MiB;
constexpr size_t WS_KMEAN = WS_BIAS + 2 * MiB;
constexpr size_t WS_SEL = WS_KMEAN + MiB;
constexpr size_t WS_WF = WS_SEL + MiB;
constexpr size_t WS_HN8 = WS_WF + MiB;
constexpr size_t WS_ORDER = WS_HN8 + (size_t)M * DM;
constexpr size_t WS_LIST = WS_ORDER + MiB;
constexpr size_t WS_PART = WS_LIST + (size_t)16 * 32 * 8192 * 4;
constexpr size_t WS_ML = WS_PART + (size_t)16 * SEQ * 4 * 128 * 2;
constexpr size_t WS_BR8 = WS_ML + (size_t)16 * SEQ * 4 * 2 * 4;
constexpr size_t WS_H1 = WS_BR8 + (size_t)M * BW;
constexpr size_t WS_H2 = WS_H1 + (size_t)M * DM * 2;
constexpr size_t WS_END = WS_H2 + (size_t)M * DM * 2;
constexpr int CW_BAR = 4096, CW_NORM = 1024  , CW_KSUM = 65536  , CW_CNT = 8192  , CW_Q = 2048  ;

constexpr int RING_BYTES = 131072, LDSCTL_OFF = 139264, MISC_OFF = LDSCTL_OFF + 320, LDS_BYTES = 147456;

__device__ __forceinline__ float wave_sum(float v) {
#pragma unroll
    for (int o = 1; o < 64; o <<= 1) v += __shfl_xor(v, o);
    return v;
}
__device__ __forceinline__ float bf2f(unsigned short b) { return __uint_as_float(((unsigned)b) << 16); }
__device__ __forceinline__ float siluf(float x) { return x * pg8::sigmoidf_fast(x); }

constexpr int TR_LD = 65, TR_BYTES = 64 * TR_LD * 4;
__device__ __forceinline__ void tr_item(const float* src, size_t ldw, bf16* dst, size_t ldt, LAS float* scr, int lane, const float* gk = nullptr  ) {
    const int l15 = lane & 15, l4 = lane >> 4;
    f32x4 v[16];
#pragma unroll
    for (int i = 0; i < 16; ++i) v[i] = __builtin_nontemporal_load((const f32x4*)(src + (size_t)(4 * i + l4) * ldw + 4 * l15));
#pragma unroll
    for (int i = 0; i < 16; ++i) { LAS float* p = scr + (4 * i + l4) * TR_LD + 4 * l15; p[0] = v[i].x; p[1] = v[i].y; p[2] = v[i].z; p[3] = v[i].w; }
    LDS_WAIT(); asm volatile("" ::: "memory");
    const int c = lane & 7;
    float g8[8];
    { f32x4 ga = {1.f, 1.f, 1.f, 1.f}, gb = ga; if (gk) { ga = *(const f32x4*)(gk + 8 * c); gb = *(const f32x4*)(gk + 8 * c + 4); }
      g8[0] = ga.x; g8[1] = ga.y; g8[2] = ga.z; g8[3] = ga.w; g8[4] = gb.x; g8[5] = gb.y; g8[6] = gb.z; g8[7] = gb.w; }
#pragma unroll
    for (int j = 0; j < 8; ++j) { const int n = (lane >> 3) + 8 * j; const LAS float* s = scr + (8 * c) * TR_LD + n;
        v4u o; o.x = pk2(s[0 * TR_LD] * g8[0], s[1 * TR_LD] * g8[1]); o.y = pk2(s[2 * TR_LD] * g8[2], s[3 * TR_LD] * g8[3]); o.z = pk2(s[4 * TR_LD] * g8[4], s[5 * TR_LD] * g8[5]); o.w = pk2(s[6 * TR_LD] * g8[6], s[7 * TR_LD] * g8[7]);
        __builtin_nontemporal_store(o, (v4u*)(dst + (size_t)n * ldt + 8 * c)); }
    LDS_WAIT(); asm volatile("" ::: "memory");
}
__device__ __forceinline__ void tr_item8(const float* src, size_t ldw, unsigned char* dst, size_t ldt, LAS float* scr, int lane, float scale, const float* gk) {
    const int l15 = lane & 15, l4 = lane >> 4;
    f32x4 v[16];
#pragma unroll
    for (int i = 0; i < 16; ++i) v[i] = __builtin_nontemporal_load((const f32x4*)(src + (size_t)(4 * i + l4) * ldw + 4 * l15));
#pragma unroll
    for (int i = 0; i < 16; ++i) { LAS float* p = scr + (4 * i + l4) * TR_LD + 4 * l15; p[0] = v[i].x; p[1] = v[i].y; p[2] = v[i].z; p[3] = v[i].w; }
    LDS_WAIT(); asm volatile("" ::: "memory");
    const int c = lane & 7;
    float g8[8];
    { f32x4 ga = {1.f, 1.f, 1.f, 1.f}, gb = ga; if (gk) { ga = *(const f32x4*)(gk + 8 * c); gb = *(const f32x4*)(gk + 8 * c + 4); }
      g8[0] = ga.x * scale; g8[1] = ga.y * scale; g8[2] = ga.z * scale; g8[3] = ga.w * scale; g8[4] = gb.x * scale; g8[5] = gb.y * scale; g8[6] = gb.z * scale; g8[7] = gb.w * scale; }
#pragma unroll
    for (int j = 0; j < 8; ++j) { const int n = (lane >> 3) + 8 * j; const LAS float* s = scr + (8 * c) * TR_LD + n;
        unsigned w0 = 0u, w1 = 0u;
        w0 = __builtin_amdgcn_cvt_pk_fp8_f32(s[0 * TR_LD] * g8[0], s[1 * TR_LD] * g8[1], w0, false); w0 = __builtin_amdgcn_cvt_pk_fp8_f32(s[2 * TR_LD] * g8[2], s[3 * TR_LD] * g8[3], w0, true);
        w1 = __builtin_amdgcn_cvt_pk_fp8_f32(s[4 * TR_LD] * g8[4], s[5 * TR_LD] * g8[5], w1, false); w1 = __builtin_amdgcn_cvt_pk_fp8_f32(s[6 * TR_LD] * g8[6], s[7 * TR_LD] * g8[7], w1, true);
        *(unsigned long long*)(dst + (size_t)n * ldt + 8 * c) = (unsigned long long)w0 | ((unsigned long long)w1 << 32); }
    LDS_WAIT(); asm volatile("" ::: "memory");
}
constexpr float WG_SCALE = 1024.0f, HN_SCALE = 16.0f, BR8_SCALE = 16.0f, WB8_SCALE = 1024.0f;
constexpr size_t W1T8_OFF = (size_t)pg8::NBFT * 256 * DM * 2;
constexpr int IT_W1A = 64 * pg8::NF8T * 4, IT_W1B = 64 * pg8::NBFT * 4, IT_WG = 64 * 256, IT_WB = 4 * 16 * 64, IT_WO = 64 * 64, IT_WP = 4 * 4 * 4;
constexpr int IT_LAYER = IT_W1A + IT_W1B + IT_WG + IT_WB + IT_WO + IT_WP;
static_assert(8 * TR_BYTES <= LDSCTL_OFF && MISC_OFF + 128 <= LDS_BYTES, "LDS map");

struct Args { const float* in[11]; float* out; unsigned char* ws; int ph_lo, ph_hi; };

struct OpsPlain { const char* A; const char* Bt; int K, lda, ldb;
    __device__ __forceinline__ const char* a_ptr(const pg8::Unit& u) const { return A + (size_t)u.pm * 256 * lda * 2; }
    __device__ __forceinline__ const char* b_ptr(const pg8::Unit& u) const { return Bt + (size_t)u.pn * 256 * ldb * 2; } };
struct OpsUp { const char* A; const char* Bt; int K, lda, ldb;
    __device__ __forceinline__ const char* a_ptr(const pg8::Unit& u) const { return A + (size_t)u.pm * 256 * 1024 * 2; }
    __device__ __forceinline__ const char* b_ptr(const pg8::Unit& u) const { return Bt + ((size_t)(u.pm >> 6) * 4096 + (size_t)u.pn * 256) * 1024 * 2; } };
struct OpsMerge { const char* A; const char* Bt; int K, lda, ldb;
    __device__ __forceinline__ const char* a_ptr(const pg8::Unit& u) const { return A + (size_t)u.pm * 256 * 4096; }
    __device__ __forceinline__ const char* b_ptr(const pg8::Unit& u) const { return Bt + ((size_t)u.z * 4096 + (size_t)u.pn * 256) * 4096; } };
struct OpsPool { const char* A; const char* Bt; int K, lda, ldb;
    __device__ __forceinline__ const char* a_ptr(const pg8::Unit& u) const { return A + (size_t)u.pm * 256 * 1024 * 2 + (size_t)u.pn * 256 * 2; }
    __device__ __forceinline__ const char* b_ptr(const pg8::Unit& u) const { return Bt + (size_t)u.pn * 256 * 256 * 2; } };

constexpr int NPL = 9, PH_FINAL = 1 + DEPTH * NPL, N_PHASES = PH_FINAL + 1;
#ifndef PH_MASK
#define PH_MASK 0x7ff
#endif
#define PHEN(k) (((PH_MASK) >> (k)) & 1)
#ifndef REP_MASK
#define REP_MASK 0
#endif
#define NREP(k) ((((REP_MASK) >> (k)) & 1) ? 2 : 1)
#ifndef ATTN_IN_KERNEL
#define ATTN_IN_KERNEL 1
#endif
#ifndef ONE_LAUNCH
#define ONE_LAUNCH 1
#endif

__global__ void __launch_bounds__(NTHR, 2) fwd(Args args) {
    extern __shared__ __attribute__((aligned(16))) unsigned char lds_raw[];
    LAS unsigned char* lds = (LAS unsigned char*)lds_raw;
    volatile LAS unsigned* MISC = (volatile LAS unsigned*)(lds + MISC_OFF);
    const int tid = threadIdx.x, lane = tid & 63, wave = __builtin_amdgcn_readfirstlane(tid >> 6);
    const int G = gridDim.x, bx = blockIdx.x;
#define KA_LOAD const Args* ka_ = &args; unsigned char* const ws = ka_->ws; gu32* const ctl = (gu32*)(ws + WS_CTL); \
    const float* const x = ka_->in[0]; const float* const norm_g = ka_->in[1]; const float* const w_in = ka_->in[2]; const float* const b_forget = ka_->in[3]; const float* const w_pool = ka_->in[4]; \
    const float* const pool_scale = ka_->in[5]; const float* const w_conv = ka_->in[6]; const float* const w_branch = ka_->in[7]; const float* const b_merge = ka_->in[8]; const float* const w_out = ka_->in[9]; \
    const float* const final_g = ka_->in[10]; float* const out = ka_->out; \
    bf16* const HN = (bf16*)(ws + WS_HN); bf16* const PROJ = (bf16*)(ws + WS_PROJ); bf16* const BR = (bf16*)(ws + WS_BR); bf16* const U = (bf16*)(ws + WS_U); bf16* const MG = (bf16*)(ws + WS_MG); bf16* const POOLED = (bf16*)(ws + WS_POOLED); \
    float* const LF = (float*)(ws + WS_LF); float* const C32 = (float*)(ws + WS_C32); v4u* const BIAS = (v4u*)(ws + WS_BIAS); float* const KMEAN = (float*)(ws + WS_KMEAN); unsigned* const SEL = (unsigned*)(ws + WS_SEL); \
    (void)ctl; (void)x; (void)norm_g; (void)w_in; (void)b_forget; (void)w_pool; (void)pool_scale; (void)w_conv; (void)w_branch; (void)b_merge; (void)w_out; (void)final_g; (void)out; \
    (void)HN; (void)PROJ; (void)BR; (void)U; (void)MG; (void)POOLED; (void)LF; (void)C32; (void)BIAS; (void)KMEAN; (void)SEL;
#define KA_LAYER const float* const win_l = w_in + (size_t)l * DM * NIN; (void)win_l;
    gu32* const ctl0 = (gu32*)(args.ws + WS_CTL);
    for (int u = tid; u < (LDS_BYTES - LDSCTL_OFF) / 4; u += NTHR) ((LAS unsigned*)(lds + LDSCTL_OFF))[u] = 0u;
    __syncthreads();
    const int lo = args.ph_lo, hi = args.ph_hi;
    const bool multi = (hi - lo) > 1;
    XcdBarrier bar; bar.bar = (unsigned*)(ctl0 + CW_BAR); bar.x = 0; bar.st = nullptr;
    if (multi) bar = xcd_barrier_post((unsigned*)(ctl0 + CW_BAR), MISC + 8);
#define IN(k) (lo <= (k) && (k) < hi)
#ifndef BAR_REP
#define BAR_REP 1
#endif
#ifndef PROBE_PH
#define PROBE_PH (-1)
#endif
    unsigned long long pt0_ = (PROBE_PH == 0) ? rt() : 0ull, pacc_ = 0ull;
#ifndef PROBE_AVG
#define PROBE_AVG (-1)
#endif
#define SEAM(k) do { if (PROBE_AVG == (k) && threadIdx.x == 0) __hip_atomic_fetch_add(ctl0 + 210, (unsigned)(rt() - pt0_), RLX_AGENT); \
        if (IN(k) && IN((k) + 1)) { for (int br_ = 0; br_ < BAR_REP; ++br_) xcd_barrier(bar); } if (PROBE_PH == (k)) pacc_ = rt() - pt0_; if (PROBE_PH == (k) + 1 || PROBE_AVG == (k) + 1) pt0_ = rt(); } while (0)
    const int NGW = G * NWAVES;
#define PHASE_IDS int tid_o = threadIdx.x; asm volatile("" : "+v"(tid_o)); const int tid = tid_o, lane = tid & 63, wave = __builtin_amdgcn_readfirstlane(tid >> 6), gw = bx * NWAVES + wave; (void)lane; (void)gw;

    for (int rep_ = 0; rep_ < NREP(0); ++rep_) if (PHEN(0) && IN(0)) { PHASE_IDS KA_LOAD
        LAS float* scr = (LAS float*)(lds + wave * TR_BYTES);
        for (int it = gw; it < DEPTH * IT_LAYER; it += NGW) {
            const int l = it / IT_LAYER; int r = it - l * IT_LAYER;
            const float* win_l = w_in + (size_t)l * DM * NIN;
            if (r < IT_W1A) { const int kb = r / (pg8::NF8T * 4), nb = r % (pg8::NF8T * 4), ct = pg8::nth_tile(nb >> 2, true), pc = ct * 256 + (nb & 3) * 64;
                tr_item8(win_l + (size_t)kb * 64 * NIN + (pc < 8192 ? pc : pc + 8), NIN, (unsigned char*)(ws + WS_W1T + l * W1T_L + W1T8_OFF) + (size_t)(nb * 64) * DM + kb * 64, DM, scr, lane, WG_SCALE, norm_g + (size_t)l * DM + kb * 64); continue; } r -= IT_W1A;
            if (r < IT_W1B) { const int kb = r / (pg8::NBFT * 4), nb = r % (pg8::NBFT * 4), ct = pg8::nth_tile(nb >> 2, false), pc = ct * 256 + (nb & 3) * 64;
                tr_item(win_l + (size_t)kb * 64 * NIN + (pc < 8192 ? pc : pc + 8), NIN, (bf16*)(ws + WS_W1T + l * W1T_L) + (size_t)(nb * 64) * DM + kb * 64, DM, scr, lane, norm_g + (size_t)l * DM + kb * 64); continue; } r -= IT_W1B;
            if (r < IT_WG) { const int kb = r / 256, nb = r % 256; tr_item8(win_l + (size_t)kb * 64 * NIN + SRC_MERGE + nb * 64, NIN, (unsigned char*)(ws + WS_WG + l * WG_L) + (size_t)(nb * 64) * DM + kb * 64, DM, scr, lane, WG_SCALE, norm_g + (size_t)l * DM + kb * 64); continue; } r -= IT_WG;
            if (r < IT_WB) { const int i = r / 1024, r2 = r % 1024, kb = r2 / 64, nb = r2 % 64;
                if (i == 0) tr_item8(w_branch + ((size_t)(l * 4) * BW + kb * 64) * DM + nb * 64, DM, (unsigned char*)(ws + WS_WB + l * WB_L) + (size_t)(nb * 64) * BW + kb * 64, BW, scr, lane, WB8_SCALE, nullptr);
                else tr_item(w_branch + ((size_t)(l * 4 + i) * BW + kb * 64) * DM + nb * 64, DM, (bf16*)(ws + WS_WB + l * WB_L) + ((size_t)i * DM + nb * 64) * BW + kb * 64, BW, scr, lane);
                continue; } r -= IT_WB;
            if (r < IT_WO) { const int kb = r / 64, nb = r % 64; tr_item(w_out + ((size_t)l * DM + kb * 64) * DM + nb * 64, DM, (bf16*)(ws + WS_WO + l * WO_L) + (size_t)(nb * 64) * DM + kb * 64, DM, scr, lane); continue; } r -= IT_WO;
            { const int g = r / 16, r2 = r % 16, kb = r2 / 4, nb = r2 % 4;
              tr_item(w_pool + ((size_t)(l * 4 + g) * 256 + kb * 64) * 256 + nb * 64, 256, (bf16*)(ws + WS_WP + l * WP_L) + ((size_t)g * 256 + nb * 64) * 256 + kb * 64, 256, scr, lane); }
        }
        for (int i = bx * NTHR + tid; i < DEPTH * DM; i += G * NTHR) { const int l = i / DM, k = i - l * DM; const float* p = w_in + ((size_t)l * DM + k) * NIN + SRC_FORGET;
            const float gk_ = norm_g[i]; const f32x4 a = *(const f32x4*)p * gk_, b = *(const f32x4*)(p + 4) * gk_; float* o = (float*)(ws + WS_WF) + (size_t)l * 8 * DM + k;
            o[0 * DM] = a.x; o[1 * DM] = a.y; o[2 * DM] = a.z; o[3 * DM] = a.w; o[4 * DM] = b.x; o[5 * DM] = b.y; o[6 * DM] = b.z; o[7 * DM] = b.w; }
    }
    SEAM(0);

    for (int l = 0; l < DEPTH; ++l) {
        const int pb = 1 + l * NPL;

        for (int rep_ = 0; rep_ < NREP(1); ++rep_) if (PHEN(1) && IN(pb + 0)) { PHASE_IDS KA_LOAD KA_LAYER
            LAS float* wfT = (LAS float*)lds;
            { const f32x4* wsrc = (const f32x4*)((const float*)(ws + WS_WF) + (size_t)l * 8 * DM);
              for (int i = tid; i < 8 * DM / 4; i += NTHR) ((LAS f32x4*)wfT)[i] = wsrc[i]; }
            __syncthreads();
            typedef unsigned u32x2_t __attribute__((ext_vector_type(2)));
#define NORM_PIECE(A_, J_) do { if (BF_) { const u32x2_t w_ = rawb[J_]; A_ = (f32x4){pg8::bf_lo(w_.x), pg8::bf_hi(w_.x), pg8::bf_lo(w_.y), pg8::bf_hi(w_.y)}; } else A_ = rawf[J_]; } while (0)
#define NORM_FETCH(ROW_, J_) do { if (BF_) rawb[J_] = *(const u32x2_t*)((const bf16*)(ws + WS_H1) + (size_t)(ROW_) * DM + 4 * (lane + 64 * (J_))); \
                else rawf[J_] = *(const f32x4*)(x + (size_t)(ROW_) * DM + 4 * (lane + 64 * (J_))); } while (0)
#define NORM_ROW(PF_) do { float ss = 0.f; \
                _Pragma("unroll") for (int j = 0; j < 16; ++j) { f32x4 a; NORM_PIECE(a, j); ss += (a.x * a.x + a.y * a.y) + (a.z * a.z + a.w * a.w); } \
                const float rstd = 1.0f / sqrtf(wave_sum(ss) * (1.0f / DM) + RMS_EPS); \
                float fa[8] = {0.f, 0.f, 0.f, 0.f, 0.f, 0.f, 0.f, 0.f}; \
                _Pragma("unroll") for (int j = 0; j < 16; ++j) { f32x4 y; NORM_PIECE(y, j); y = y * rstd; const int e0 = 4 * (lane + 64 * j); \
                    if (PF_) NORM_FETCH(row + NGW, j); \
                    *(u32x2_t*)(HN + (size_t)row * DM + e0) = (u32x2_t){pk2(y.x, y.y), pk2(y.z, y.w)}; \
                    { unsigned w8 = 0u; w8 = __builtin_amdgcn_cvt_pk_fp8_f32(__builtin_amdgcn_fmed3f(y.x * HN_SCALE, -440.f, 440.f), __builtin_amdgcn_fmed3f(y.y * HN_SCALE, -440.f, 440.f), w8, false); w8 = __builtin_amdgcn_cvt_pk_fp8_f32(__builtin_amdgcn_fmed3f(y.z * HN_SCALE, -440.f, 440.f), __builtin_amdgcn_fmed3f(y.w * HN_SCALE, -440.f, 440.f), w8, true); \
                      *(unsigned*)(ws + WS_HN8 + (size_t)row * DM + e0) = w8; } \
                    _Pragma("unroll") for (int h = 0; h < 8; ++h) { const f32x4 w = *(const LAS f32x4*)(wfT + h * DM + e0); fa[h] += (y.x * w.x + y.y * w.y) + (y.z * w.z + y.w * w.w); } \
                    asm volatile("" ::: "memory"); } \
                _Pragma("unroll") for (int h = 0; h < 8; ++h) fa[h] = wave_sum(fa[h]); \
                float mine = fa[0]; \
                _Pragma("unroll") for (int h = 1; h < 8; ++h) mine = (lane == h) ? fa[h] : mine; \
                if (lane < 8) { const float z = mine + b_forget[l * NH + lane]; const float ls = fminf(z, 0.f) - 0.6931471805599453f * __builtin_amdgcn_logf(1.0f + __builtin_amdgcn_exp2f(-1.4426950408889634f * fabsf(z))); \
                    LF[((size_t)(row / SEQ) * NH + lane) * SEQ + (row % SEQ)] = ls; } } while (0)
            if (gw < M) {
                if (l == 0) { constexpr bool BF_ = false; f32x4 rawf[16]; u32x2_t rawb[1]; (void)rawb;
#pragma unroll
                    for (int j = 0; j < 16; ++j) NORM_FETCH(gw, j);
                    int row = gw; for (; row + NGW < M; row += NGW) NORM_ROW(true); NORM_ROW(false); }
                else { constexpr bool BF_ = true; u32x2_t rawb[16]; f32x4 rawf[1]; (void)rawf;
#pragma unroll
                    for (int j = 0; j < 16; ++j) NORM_FETCH(gw, j);
                    int row = gw; for (; row + NGW < M; row += NGW) NORM_ROW(true); NORM_ROW(false); } }
#undef NORM_ROW
#undef NORM_FETCH
#undef NORM_PIECE
        }
        SEAM(pb + 0);

        for (int rep_ = 0; rep_ < NREP(2); ++rep_) if (PHEN(2) && IN(pb + 1)) { KA_LOAD KA_LAYER
            { OpsPlain O{(const char*)(ws + WS_HN8), (const char*)(ws + WS_W1T + l * W1T_L + W1T8_OFF), DM / 2, DM / 2, DM / 2};
              pg8::StaticOrder S; S.init(M, pg8::NF8T * 256, G, bx);
              pg8::EpiProj<0> E{PROJ, N1, (float*)((unsigned*)ctl + CW_KSUM + l * 65536), (unsigned*)ctl + CW_NORM + l * 128, 1.0f / (WG_SCALE * HN_SCALE)};
              pg8::gemm_phase<pg8::EpiProj<0>, pg8::StaticOrder, OpsPlain, true, true, 1>(lds, O, S, E); }
            { OpsPlain O{(const char*)HN, (const char*)(ws + WS_W1T + l * W1T_L), DM, DM, DM};
              pg8::StaticOrder S; S.init(M, pg8::NBFT * 256, G, bx);
              pg8::EpiProj<1> E{PROJ, N1, (float*)((unsigned*)ctl + CW_KSUM + l * 65536), (unsigned*)ctl + CW_NORM + l * 128, 1.0f};
              pg8::gemm_phase<pg8::EpiProj<1>, pg8::StaticOrder, OpsPlain, true, true, 0>(lds, O, S, E); }
        }
        SEAM(pb + 1);

        for (int rep_ = 0; rep_ < NREP(3); ++rep_) if (PHEN(3) && IN(pb + 2)) { PHASE_IDS KA_LOAD KA_LAYER
            { LAS double* sd = (LAS double*)lds;
              for (int ub = G - 1 - bx; ub < BATCH * NH; ub += G) { const float* lf = LF + (size_t)ub * SEQ + 16 * tid; double loc[16]; double run = 0.0;
#pragma unroll
                for (int k = 0; k < 16; ++k) { run += (double)lf[k]; loc[k] = run; }
                sd[tid] = run; __syncthreads();
                for (int off = 1; off < NTHR; off <<= 1) { const double vv = (tid >= off) ? sd[tid - off] : 0.0; __syncthreads(); sd[tid] += vv; __syncthreads(); }
                const double excl = sd[tid] - run;
#pragma unroll
                for (int k = 0; k < 16; ++k) { const double c = excl + loc[k]; C32[(size_t)ub * SEQ + 16 * tid + k] = (float)c;
                    const double xx = -c * 11.313708498984761; const unsigned b1 = f2bf((float)xx); const double r1 = xx - (double)__uint_as_float(b1 << 16);
                    const unsigned b2 = f2bf((float)r1); const double r2 = r1 - (double)__uint_as_float(b2 << 16); const unsigned b3 = f2bf((float)r2);
                    BIAS[(size_t)ub * SEQ + 16 * tid + k] = (v4u){b1 | (b2 << 16), b3, 0u, 0u}; }
                __syncthreads(); } }
            { const float* wc_l = w_conv + (size_t)l * 3 * BW;
              for (int idx = bx * NTHR + tid; idx < (M / 16) * 128; idx += G * NTHR) { const int row0 = (idx >> 7) * 16, col = (idx & 127) * 8, t0 = row0 & (SEQ - 1);
#define LD8(f_, p_) do { const v4u w_ = *(const v4u*)(p_); f_[0] = pg8::bf_lo(w_.x); f_[1] = pg8::bf_hi(w_.x); f_[2] = pg8::bf_lo(w_.y); f_[3] = pg8::bf_hi(w_.y); f_[4] = pg8::bf_lo(w_.z); f_[5] = pg8::bf_hi(w_.z); f_[6] = pg8::bf_lo(w_.w); f_[7] = pg8::bf_hi(w_.w); } while (0)
                { const int win = 2 << (col >> 8); const bf16* p = PROJ + (size_t)row0 * N1 + C_IN + col; float sacc[8] = {0.f, 0.f, 0.f, 0.f, 0.f, 0.f, 0.f, 0.f};
                  for (int j = win - 1; j >= 1; --j) if (t0 - j >= 0) { float f[8]; LD8(f, p - (ptrdiff_t)j * (ptrdiff_t)N1);
#pragma unroll
                      for (int e = 0; e < 8; ++e) sacc[e] += f[e]; }
#pragma unroll 4
                  for (int i = 0; i < 16; ++i) { const int t = t0 + i; float f[8]; LD8(f, p + (size_t)i * N1);
#pragma unroll
                      for (int e = 0; e < 8; ++e) sacc[e] += f[e];
                      { const bool lv = i > 0 && t - win >= 0; float g[8]; LD8(g, p + (lv ? (ptrdiff_t)(i - win) * (ptrdiff_t)N1 : (ptrdiff_t)0));
#pragma unroll
                        for (int e = 0; e < 8; ++e) sacc[e] -= lv ? g[e] : 0.f; }
                      const float inv = 1.0f / (float)((t + 1 < win) ? t + 1 : win); float o[8];
#pragma unroll
                      for (int e = 0; e < 8; ++e) o[e] = sacc[e] * inv - f[e];
                      *(v4u*)(POOLED + (size_t)(row0 + i) * BW + col) = (v4u){pk2(o[0], o[1]), pk2(o[2], o[3]), pk2(o[4], o[5]), pk2(o[6], o[7])}; } }
                { float w0[8], w1[8], w2[8], zp[8], zpp[8]; const bf16* p = PROJ + (size_t)row0 * N1 + col;
                  { const f32x4 a0 = *(const f32x4*)(wc_l + col), a1 = *(const f32x4*)(wc_l + col + 4), b0 = *(const f32x4*)(wc_l + BW + col), b1 = *(const f32x4*)(wc_l + BW + col + 4), c0 = *(const f32x4*)(wc_l + 2 * BW + col), c1 = *(const f32x4*)(wc_l + 2 * BW + col + 4);
#pragma unroll
                    for (int e = 0; e < 4; ++e) { w0[e] = a0[e]; w0[4 + e] = a1[e]; w1[e] = b0[e]; w1[4 + e] = b1[e]; w2[e] = c0[e]; w2[4 + e] = c1[e]; } }
#pragma unroll
                  for (int e = 0; e < 8; ++e) { zp[e] = 0.f; zpp[e] = 0.f; }
                  if (t0 >= 2) { float c[8], xx[8]; LD8(c, p - 2 * (ptrdiff_t)N1 + D_C); LD8(xx, p - 2 * (ptrdiff_t)N1 + D_X);
#pragma unroll
                      for (int e = 0; e < 8; ++e) zpp[e] = c[e] * xx[e]; }
                  if (t0 >= 1) { float c[8], xx[8]; LD8(c, p - (ptrdiff_t)N1 + D_C); LD8(xx, p - (ptrdiff_t)N1 + D_X);
#pragma unroll
                      for (int e = 0; e < 8; ++e) zp[e] = c[e] * xx[e]; }
#pragma unroll 4
                  for (int i = 0; i < 16; ++i) { const bf16* pr = p + (size_t)i * N1; float c[8], xx[8], bb[8], gg[8], o[8]; LD8(c, pr + D_C); LD8(xx, pr + D_X); LD8(bb, pr + D_B); LD8(gg, pr + D_G);
#pragma unroll
                      for (int e = 0; e < 8; ++e) { const float z = c[e] * xx[e]; const float y = w0[e] * zpp[e] + w1[e] * zp[e] + w2[e] * z; zpp[e] = zp[e]; zp[e] = z; o[e] = bb[e] * y * siluf(gg[e]); }
                      *(v4u*)(BR + ((size_t)3 * M + row0 + i) * BW + col) = (v4u){pk2(o[0], o[1]), pk2(o[2], o[3]), pk2(o[4], o[5]), pk2(o[6], o[7])}; } }
#undef LD8
              } }
        }
        SEAM(pb + 2);

        for (int rep_ = 0; rep_ < NREP(4); ++rep_) if (PHEN(4) && IN(pb + 3)) { PHASE_IDS KA_LOAD KA_LAYER
#ifndef SUBREP
#define SUBREP 0
#endif
#ifndef STAG_US
#define STAG_US 0
#endif
#ifndef FOX_OVH
#define FOX_OVH 3
#endif
            for (int sr_ = 0; sr_ < ((SUBREP == 1) ? 2 : 1); ++sr_)
            { LAS float* km = (LAS float*)lds;
              const int nsw = (G > 16) ? G - 8 : G;
              const int half = tid >> 8, ti = tid & 255;
              for (int base = (bx < nsw ? bx : 256); base < 256; base += 2 * nsw) { const int un = base + half * nsw; const bool act = un < 256; const int bhs = act ? (un >> 4) : 0, y = un & 15;
                const float* ksrc = (const float*)((const unsigned*)ctl + CW_KSUM + l * 65536) + (size_t)bhs * NBLK * HD; LAS float* kmh = km + half * 4096;
                if (act) { const f32x4* k4 = (const f32x4*)ksrc; LAS f32x4* d4 = (LAS f32x4*)kmh; f32x4 tmp[4];
#pragma unroll
                    for (int i = 0; i < 4; ++i) { const int e = ti + 256 * i; tmp[i] = (e < 992) ? k4[e] : (f32x4){0.f, 0.f, 0.f, 0.f}; }
#pragma unroll
                    for (int i = 0; i < 4; ++i) { const int e = ti + 256 * i; if (e < 992) d4[e] = tmp[i] * (1.0f / 256.0f); } }
                __syncthreads();
                if (act) for (int pass = 0; pass < 2; ++pass) { const int qb = pass ? 31 - y : y, t = qb * 256 + ti;
                    const size_t row = (size_t)(bhs >> 3) * SEQ + t; const v4u* qp4 = (const v4u*)(PROJ + row * N1 + A_Q + (bhs & 7) * HD); v4u qv[16];
#pragma unroll
                    for (int i = 0; i < 16; ++i) qv[i] = qp4[i];
                    float v0 = -3.0e38f, v1 = -3.0e38f, v2 = -3.0e38f; int i0 = -1, i1 = -1, i2 = -1;
                    for (int n = 0; n < qb; ++n) { float s0 = 0.f, s1 = 0.f, s2 = 0.f, s3 = 0.f; const LAS f32x4* kr = (const LAS f32x4*)(kmh + n * HD);
#pragma unroll
                        for (int i = 0; i < 16; ++i) { const f32x4 ka = kr[2 * i], kb = kr[2 * i + 1];
                            s0 += pg8::bf_lo(qv[i].x) * ka.x; s1 += pg8::bf_hi(qv[i].x) * ka.y; s2 += pg8::bf_lo(qv[i].y) * ka.z; s3 += pg8::bf_hi(qv[i].y) * ka.w;
                            s0 += pg8::bf_lo(qv[i].z) * kb.x; s1 += pg8::bf_hi(qv[i].z) * kb.y; s2 += pg8::bf_lo(qv[i].w) * kb.z; s3 += pg8::bf_hi(qv[i].w) * kb.w; }
                        const float sc_ = (s0 + s1) + (s2 + s3);
                        if (sc_ > v0) { v2 = v1; i2 = i1; v1 = v0; i1 = i0; v0 = sc_; i0 = n; } else if (sc_ > v1) { v2 = v1; i2 = i1; v1 = sc_; i1 = n; } else if (sc_ > v2) { v2 = sc_; i2 = n; } }
                    unsigned mask = 1u << qb; if (i0 >= 0) mask |= 1u << i0; if (i1 >= 0) mask |= 1u << i1; if (i2 >= 0) mask |= 1u << i2;
                    SEL[(size_t)bhs * SEQ + t] = mask;
                    { const unsigned long long lt = (1ull << lane) - 1ull; int r0 = 0, r1 = 0, r2 = 0, mycnt = 0;
                      for (int nn = 0; nn < qb; ++nn) { const unsigned long long m0 = __ballot(i0 == nn), m1 = __ballot(i1 == nn), m2 = __ballot(i2 == nn); const int c0 = __popcll(m0), c1 = __popcll(m1);
                          if (i0 == nn) r0 = __popcll(m0 & lt); if (i1 == nn) r1 = c0 + __popcll(m1 & lt); if (i2 == nn) r2 = c0 + c1 + __popcll(m2 & lt);
                          if (lane == nn) mycnt = c0 + c1 + __popcll(m2); }
                      unsigned basev = 0u; if (lane < qb && mycnt > 0) basev = __hip_atomic_fetch_add(ctl + CW_CNT + l * 512 + bhs * 32 + lane, (unsigned)mycnt, RLX_AGENT);
                      const unsigned b0 = (unsigned)__shfl((int)basev, i0 < 0 ? 0 : i0), b1 = (unsigned)__shfl((int)basev, i1 < 0 ? 0 : i1), b2 = (unsigned)__shfl((int)basev, i2 < 0 ? 0 : i2);
                      unsigned* LISTS = (unsigned*)(ws + WS_LIST) + (size_t)bhs * 32 * 8192;
                      if (i0 >= 0) LISTS[(size_t)i0 * 8192 + b0 + r0] = (unsigned)t;
                      if (i1 >= 0) LISTS[(size_t)i1 * 8192 + b1 + r1] = (unsigned)t | (1u << 16);
                      if (i2 >= 0) LISTS[(size_t)i2 * 8192 + b2 + r2] = (unsigned)t | (2u << 16); } }
                __syncthreads(); } }
            for (int sr_ = 0; sr_ < ((SUBREP == 2) ? 2 : 1); ++sr_)
            if (bx >= G - 8) { const int vq = G - 1 - bx;
                LAS int* wsh = (LAS int*)lds; LAS int* wbh = wsh + 512; LAS int* pr2 = wbh + 16; LAS int* itw = pr2 + 16; LAS int* srt = itw + 128; LAS int* load = srt + 128; LAS int* asg = load + 32;
                const int bh = tid >> 5, qb = tid & 31;
                float qm2 = 0.f, km2 = 0.f;
#pragma unroll
                for (int g4 = 0; g4 < 4; ++g4) { qm2 += __uint_as_float(__hip_atomic_load((unsigned*)ctl + CW_NORM + l * 128 + (bh * 2) * 4 + g4, __ATOMIC_RELAXED, __HIP_MEMORY_SCOPE_AGENT)); km2 += __uint_as_float(__hip_atomic_load((unsigned*)ctl + CW_NORM + l * 128 + (bh * 2 + 1) * 4 + g4, __ATOMIC_RELAXED, __HIP_MEMORY_SCOPE_AGENT)); }
                const float TH = 2.0f * sqrtf(qm2 * km2) * 0.08838834764831845f + 40.0f; const float c0 = C32[(size_t)bh * SEQ + qb * 256];
                LAS float* cend = (LAS float*)(lds + 32768);
#pragma unroll
                for (int i = 0; i < 4; ++i) { const int e = tid * 4 + i; cend[e] = C32[(size_t)(e >> 7) * SEQ + 64 * (e & 127) + 63]; }
                __syncthreads();
                int lo_ = 0, hi_ = 4 * qb;
                while (lo_ < hi_) { const int mid = (lo_ + hi_) >> 1; if (cend[bh * 128 + mid] - c0 > TH) lo_ = mid + 1; else hi_ = mid; }
                lo_ &= ~1;
                wsh[tid] = (4 * (qb + 1) - lo_ + FOX_OVH) | (lo_ << 16); __syncthreads();
                if (tid < 16) { int sacc = 0; for (int j = 0; j < 32; ++j) sacc += wsh[tid * 32 + j] & 0xffff; wbh[tid] = sacc; } __syncthreads();
                if (tid < 16) { const int b_ = tid >> 3, h_ = tid & 7; int rk = 0; for (int j = 0; j < 8; ++j) { const int wj = wbh[b_ * 8 + j]; rk += (wj > wbh[tid] || (wj == wbh[tid] && j < h_)) ? 1 : 0; }
                    const int p_ = rk < 4 ? rk : 7 - rk; pr2[(b_ * 4 + p_) * 2 + (rk < 4 ? 0 : 1)] = tid; }
                __syncthreads();
                int myw = 0; unsigned myent = 0u;
                if (tid < 64) { const int qq = tid & 31, fb = pr2[vq * 2 + (tid >> 5)], v = wsh[fb * 32 + qq]; myw = v & 0xffff; myent = ((unsigned)(v >> 16) << 16) | (unsigned)(fb * 32 + qq); itw[tid] = myw; }
                __syncthreads();
                if (tid < 64) { int r = 0; for (int j = 0; j < 64; ++j) { const int wj = itw[j]; r += (wj > myw || (wj == myw && j < tid)) ? 1 : 0; } srt[r] = tid; }
                __syncthreads();
                if (tid < 32) { const int it = srt[tid]; load[tid] = itw[it]; asg[tid * 4] = it; } __syncthreads();
                { int r = 0, mine = 0;
                  if (tid < 32) { mine = load[tid]; for (int j = 0; j < 32; ++j) { const int lj = load[j]; r += (lj < mine || (lj == mine && j < tid)) ? 1 : 0; } }
                  __syncthreads();
                  if (tid < 32) { const int it = srt[32 + r]; load[tid] = mine + itw[it]; asg[tid * 4 + 1] = it; }
                  __syncthreads(); }
                LAS unsigned* ent = (LAS unsigned*)(asg + 128); if (tid < 64) ent[tid] = myent; __syncthreads();
                if (tid < 32) { unsigned* dst = (unsigned*)(ws + WS_ORDER) + (vq + 8 * tid) * 16;
                    dst[8] = ent[asg[tid * 4]]; dst[9] = ent[asg[tid * 4 + 1]]; const unsigned two_ = 2u + ((unsigned)tid >> 9);
                    dst[0] = two_ - 2u; dst[1] = two_; dst[2] = (unsigned)load[tid]; }
                __syncthreads(); }
            for (int sr_ = 0; sr_ < ((SUBREP == 3) ? 2 : 1); ++sr_)
            { OpsPool O{(const char*)POOLED, (const char*)(ws + WS_WP + l * WP_L), 256, BW, 256};
              pg8::StaticOrder S; S.init(M, BW, G, bx);
              pg8::EpiPool E{BR + (size_t)2 * M * BW, BW, pool_scale + (size_t)l * BW, PROJ + C_G, N1};
              pg8::gemm_phase<pg8::EpiPool, pg8::StaticOrder, OpsPool, true, true>(lds, O, S, E); }
        }
        SEAM(pb + 3);

        for (int rep_ = 0; rep_ < NREP(5); ++rep_) if (PHEN(5) && IN(pb + 4)) { KA_LOAD KA_LAYER
#if ATTN_IN_KERNEL
            const unsigned* LST = (const unsigned*)(ws + WS_ORDER);
#define ATT_REF(E_, R_) do { const unsigned e_ = (E_); (R_).bh = (int)((e_ >> 5) & 15u); (R_).qb = (int)(e_ & 31u); (R_).j0 = (int)(e_ >> 16); (R_).kind = 0; (R_).lbase = 0; (R_).nval = 256; } while (0)
            const att::Bases BS{PROJ, BR, BIAS, SEL, (const unsigned*)(ws + WS_LIST), (bf16*)(ws + WS_PART), (float*)(ws + WS_ML)};
#define ATT_STREAM(MODE_) do { for (int bin = bx; bin < 256; bin += G) { const unsigned* rec = LST + bin * 16; const int n_ = (int)rec[(MODE_) ? 1 : 0]; \
                if (n_ > 0) { const unsigned* ents = rec + ((MODE_) ? 8 : 4); att::BlockRef cur, nxt; ATT_REF(ents[0], cur); att::Seam S; att::attn_prime<MODE_>(BS, cur, (char*)lds_raw, S); \
                    for (int k_ = 0; k_ < n_; ++k_) { if (k_ + 1 < n_) ATT_REF(ents[k_ + 1], nxt); else nxt = cur; att::attn_block<MODE_>(BS, cur, nxt, (char*)lds_raw, S); cur = nxt; } } } } while (0)
            for (int ar_ = 0; ar_ < ((SUBREP == 5) ? 2 : 1); ++ar_)
            ATT_STREAM(1);
#if DIAG_MOBA == 1
            for (int idx = bx; idx < 512; idx += G) { att::BlockRef cur; cur.bh = idx & 15; cur.qb = idx >> 4; cur.j0 = 0; cur.kind = 0; cur.lbase = 0; cur.nval = 256; att::Seam S; att::attn_prime<0>(BS, cur, (char*)lds_raw, S); att::attn_block<0>(BS, cur, cur, (char*)lds_raw, S); }
#endif
            for (int ar_ = 0; ar_ < ((SUBREP == 6) ? 2 : 1); ++ar_)
            for (int bin = bx; bin < 256; bin += G) { const int vx = bin & 7, lb = bin >> 3;
                LAS int* PFX = (LAS int*)(lds + 98304); LAS int* CNL = PFX + 64; LAS int* UR = CNL + 64;
                __syncthreads();
                int tj_ = threadIdx.x; asm volatile("" : "+v"(tj_));
                if (tj_ < 64) { const int j = tj_; const int c = (int)__hip_atomic_load(ctl + CW_CNT + l * 512 + (2 * vx + (j >> 5)) * 32 + (j & 31), RLX_AGENT); const int ch = (c + 255) >> 8;
                    int inc = ch;
#pragma unroll
                    for (int o = 1; o < 64; o <<= 1) { const int v = __shfl_up(inc, o); if (j >= o) inc += v; }
                    PFX[j] = inc - ch; CNL[j] = c; const int U = 64 + __shfl(inc, 63);
                    const int Li = (j < 32) ? (int)LST[(vx + 8 * j) * 16 + 2] : 0x3fffffff; constexpr int WU = 8;
                    int lo_ = 0, hi_ = 8192;
                    while (lo_ < hi_) { const int mid = (lo_ + hi_) >> 1; int ni = (mid > Li) ? (mid - Li) / WU : 0;
#pragma unroll
                        for (int o = 1; o < 64; o <<= 1) ni += __shfl_xor(ni, o);
                        if (ni >= U) hi_ = mid; else lo_ = mid + 1; }
                    int ni = (lo_ > Li) ? (lo_ - Li) / WU : 0; int tot = ni;
#pragma unroll
                    for (int o = 1; o < 64; o <<= 1) tot += __shfl_xor(tot, o);
                    int excess = tot - U;
                    while (excess > 0) { const unsigned long long pm = __ballot(ni > 0); const int rk = __popcll(pm & ((1ull << j) - 1ull)); if (ni > 0 && rk < excess) --ni; const int np = __popcll(pm); excess -= (np < excess ? np : excess); }
                    int inc2 = ni;
#pragma unroll
                    for (int o = 1; o < 64; o <<= 1) { const int v = __shfl_up(inc2, o); if (j >= o) inc2 += v; }
                    if (j == lb) { UR[0] = inc2 - ni; UR[1] = ni; } }
                __syncthreads();
                const int u0 = __builtin_amdgcn_readfirstlane(UR[0]), un = __builtin_amdgcn_readfirstlane(UR[1]);
#define ATT_UNIT(U_, R_) do { const int u_ = (U_); if (u_ < 64) { (R_).bh = 2 * vx + (u_ >> 5); (R_).qb = u_ & 31; (R_).j0 = 4 * (u_ & 31); (R_).kind = 0; (R_).lbase = 0; (R_).nval = 256; } \
                    else { const int g_ = u_ - 64; int a_ = 0, b_ = 63; while (a_ < b_) { const int m_ = (a_ + b_ + 1) >> 1; if (__builtin_amdgcn_readfirstlane(PFX[m_]) <= g_) a_ = m_; else b_ = m_ - 1; } \
                        const int ck_ = g_ - __builtin_amdgcn_readfirstlane(PFX[a_]), cn_ = __builtin_amdgcn_readfirstlane(CNL[a_]) - ck_ * 256; (R_).bh = 2 * vx + (a_ >> 5); (R_).qb = 0; (R_).j0 = 4 * (a_ & 31); (R_).kind = 1; \
                        (R_).lbase = ((R_).bh * 32 + (a_ & 31)) * 8192 + ck_ * 256; (R_).nval = cn_ < 256 ? cn_ : 256; } } while (0)
                if (un > 0) { att::BlockRef cur, nxt; ATT_UNIT(u0, cur); att::Seam S; att::attn_prime<2>(BS, cur, (char*)lds_raw, S);
                    for (int k_ = 0; k_ < un; ++k_) { if (k_ + 1 < un) ATT_UNIT(u0 + k_ + 1, nxt); else nxt = cur; att::attn_block<2>(BS, cur, nxt, (char*)lds_raw, S); cur = nxt; } }
#undef ATT_UNIT
            }
#undef ATT_STREAM
#undef ATT_REF
#endif
        }
        SEAM(pb + 4);

        if (PHEN(6) && IN(pb + 5)) { PHASE_IDS KA_LOAD KA_LAYER
            const bf16* PART = (const bf16*)(ws + WS_PART); const float* ML = (const float*)(ws + WS_ML);
#pragma unroll 2
            for (int idx = bx * NTHR + tid; idx < M * 128; idx += G * NTHR) { const int row = idx >> 7, col = (idx & 127) * 8, b = row >> 13, t = row & (SEQ - 1), h = col >> 7, d = col & 127, qb = t >> 8;
                const size_t pb4 = ((size_t)((b * NH + h) * SEQ + t)) * 4; const int nsel = qb < 3 ? qb : 3;
                const f32x4 ml01 = *(const f32x4*)(ML + pb4 * 2), ml23 = *(const f32x4*)(ML + pb4 * 2 + 4);
                const float mv[4] = {ml01.x, ml01.z, ml23.x, ml23.z}, lv[4] = {ml01.y, ml01.w, ml23.y, ml23.w};
                float mx = mv[3];
#pragma unroll
                for (int q = 0; q < 3; ++q) if (q < nsel) mx = fmaxf(mx, mv[q]);
                float cf[4], den = 0.f;
#pragma unroll
                for (int q = 0; q < 4; ++q) { const bool on = (q == 3) || (q < nsel); cf[q] = on ? __builtin_amdgcn_exp2f((mv[q] - mx) * (1.4426950408889634f * 0.08838834764831845f)) * lv[q] : 0.f; den += cf[q]; }
                const float rden = 1.0f / den; float o[8] = {0.f, 0.f, 0.f, 0.f, 0.f, 0.f, 0.f, 0.f};
#pragma unroll
                for (int q = 0; q < 4; ++q) { v4u w = *(const v4u*)(PART + (pb4 + q) * 128 + d); if (!((q == 3) || (q < nsel))) w = (v4u){0u, 0u, 0u, 0u};
                    const float c_ = cf[q] * rden;
                    o[0] += c_ * pg8::bf_lo(w.x); o[1] += c_ * pg8::bf_hi(w.x); o[2] += c_ * pg8::bf_lo(w.y); o[3] += c_ * pg8::bf_hi(w.y); o[4] += c_ * pg8::bf_lo(w.z); o[5] += c_ * pg8::bf_hi(w.z); o[6] += c_ * pg8::bf_lo(w.w); o[7] += c_ * pg8::bf_hi(w.w); }
                const v4u gw_ = *(const v4u*)(PROJ + (size_t)row * N1 + A_G + col);
                const float gg[8] = {pg8::bf_lo(gw_.x), pg8::bf_hi(gw_.x), pg8::bf_lo(gw_.y), pg8::bf_hi(gw_.y), pg8::bf_lo(gw_.z), pg8::bf_hi(gw_.z), pg8::bf_lo(gw_.w), pg8::bf_hi(gw_.w)};
#pragma unroll
                for (int e = 0; e < 8; ++e) o[e] *= siluf(gg[e]);
#if DIAG_MOBA
                if (DIAG_MOBA == 1 || DIAG_MOBA == 3 || DIAG_MOBA == 4 || l == 0) { const v4u dw = *(const v4u*)(U + (size_t)row * BW + col); const float dd[8] = {pg8::bf_lo(dw.x), pg8::bf_hi(dw.x), pg8::bf_lo(dw.y), pg8::bf_hi(dw.y), pg8::bf_lo(dw.z), pg8::bf_hi(dw.z), pg8::bf_lo(dw.w), pg8::bf_hi(dw.w)};
#pragma unroll
                  for (int e = 0; e < 8; ++e) { const float df = fabsf(o[e] - dd[e]); if (df > DIAG_TOL * (fabsf(o[e]) + fabsf(dd[e])) + 2e-3f) atomicAdd((unsigned*)ctl + 200 + l, 1u); } }
#endif
                *(v4u*)(BR + (size_t)row * BW + col) = (v4u){pk2(o[0], o[1]), pk2(o[2], o[3]), pk2(o[4], o[5]), pk2(o[6], o[7])};
                { float q8[8];
#pragma unroll
                  for (int e = 0; e < 8; ++e) q8[e] = fminf(fmaxf(o[e] * BR8_SCALE, -440.0f), 440.0f);
                  unsigned w0 = 0u, w1 = 0u; w0 = __builtin_amdgcn_cvt_pk_fp8_f32(q8[0], q8[1], w0, false); w0 = __builtin_amdgcn_cvt_pk_fp8_f32(q8[2], q8[3], w0, true);
                  w1 = __builtin_amdgcn_cvt_pk_fp8_f32(q8[4], q8[5], w1, false); w1 = __builtin_amdgcn_cvt_pk_fp8_f32(q8[6], q8[7], w1, true);
                  *(unsigned long long*)(ws + WS_BR8 + (size_t)row * BW + col) = (unsigned long long)w0 | ((unsigned long long)w1 << 32); } }
        }
#if DIAG_MOBA == 4
        if (PHEN(6) && IN(pb + 5)) { PHASE_IDS KA_LOAD KA_LAYER
            for (int idx = bx * NTHR + tid; idx < M * 128; idx += G * NTHR) { const size_t o_ = (size_t)M * BW + (size_t)(idx >> 7) * BW + (idx & 127) * 8; const v4u aw = *(const v4u*)(BR + o_), dw = *(const v4u*)(U + o_);
                const float av[8] = {pg8::bf_lo(aw.x), pg8::bf_hi(aw.x), pg8::bf_lo(aw.y), pg8::bf_hi(aw.y), pg8::bf_lo(aw.z), pg8::bf_hi(aw.z), pg8::bf_lo(aw.w), pg8::bf_hi(aw.w)};
                const float dv[8] = {pg8::bf_lo(dw.x), pg8::bf_hi(dw.x), pg8::bf_lo(dw.y), pg8::bf_hi(dw.y), pg8::bf_lo(dw.z), pg8::bf_hi(dw.z), pg8::bf_lo(dw.w), pg8::bf_hi(dw.w)};
#pragma unroll
                for (int e = 0; e < 8; ++e) { const float df = fabsf(av[e] - dv[e]); if (df > DIAG_TOL * (fabsf(av[e]) + fabsf(dv[e])) + 4e-3f) atomicAdd((unsigned*)ctl + 200 + l, 1u); } } }
#endif
        SEAM(pb + 5);

        for (int rep_ = 0; rep_ < NREP(7); ++rep_) if (PHEN(7) && IN(pb + 6)) { KA_LOAD KA_LAYER
            if (STAG_US > 0) { const unsigned long long te_ = rt() + (unsigned long long)((bx & 3) * STAG_US * 100); while (rt() < te_) __builtin_amdgcn_s_sleep(8); }
            { OpsPlain O{(const char*)(ws + WS_BR8), (const char*)(ws + WS_WB + l * WB_L), BW / 2, BW / 2, BW / 2};
              pg8::StaticOrder S; S.init(M, DM, G, bx);
              pg8::EpiStoreBf16 E{U, DM, 1.0f / (BR8_SCALE * WB8_SCALE)};
              pg8::gemm_phase<pg8::EpiStoreBf16, pg8::StaticOrder, OpsPlain, true, true, 1>(lds, O, S, E); }
            { OpsUp O{(const char*)(BR + (size_t)M * BW), (const char*)(ws + WS_WB + l * WB_L + (size_t)DM * BW * 2), BW, BW, BW};
              pg8::StaticOrder S; S.init(3 * M, DM, G, bx);
              pg8::EpiStoreBf16 E{U + (size_t)M * DM, DM, 1.0f};
              pg8::gemm_phase<pg8::EpiStoreBf16, pg8::StaticOrder, OpsUp, true, true>(lds, O, S, E); }
        }
        SEAM(pb + 6);

        for (int rep_ = 0; rep_ < NREP(8); ++rep_) if (PHEN(8) && IN(pb + 7)) { KA_LOAD KA_LAYER
            if (STAG_US > 0) { const unsigned long long te_ = rt() + (unsigned long long)((bx & 3) * STAG_US * 100); while (rt() < te_) __builtin_amdgcn_s_sleep(8); }
            OpsMerge O{(const char*)(ws + WS_HN8), (const char*)(ws + WS_WG + l * WG_L), DM / 2, DM / 2, DM / 2};
            pg8::QuadOrder S; S.base.init(M, DM, G, bx);
            pg8::EpiMerge E{MG, U, b_merge + (size_t)l * 4 * DM, 1.0f / (WG_SCALE * HN_SCALE)};
            pg8::gemm_phase<pg8::EpiMerge, pg8::QuadOrder, OpsMerge, true, true, 1>(lds, O, S, E);
        }
        SEAM(pb + 7);

        for (int rep_ = 0; rep_ < (l == 0 ? NREP(9) : 1); ++rep_) if (PHEN(9) && IN(pb + 8)) { KA_LOAD KA_LAYER
            OpsPlain O{(const char*)MG, (const char*)(ws + WS_WO + l * WO_L), DM, DM, DM};
            pg8::StaticOrder S; S.init(M, DM, G, bx);
            pg8::EpiResid E{l == 0 ? x : (const float*)nullptr, (const bf16*)(ws + WS_H1), (bf16*)(ws + (l == 0 ? WS_H1 : WS_H2))};
            pg8::gemm_phase<pg8::EpiResid, pg8::StaticOrder, OpsPlain, true, true>(lds, O, S, E);
        }
        SEAM(pb + 8);
    }

    if (PHEN(10) && IN(PH_FINAL)) { PHASE_IDS KA_LOAD
        f32x4 gv[16];
#pragma unroll
        for (int c = 0; c < 8; ++c) { gv[2 * c] = *(const f32x4*)(final_g + 8 * (lane + 64 * c)); gv[2 * c + 1] = *(const f32x4*)(final_g + 8 * (lane + 64 * c) + 4); }
        for (int row = gw; row < M; row += NGW) {
            const bf16* hr = (const bf16*)(ws + WS_H2) + (size_t)row * DM; float* orow = out + (size_t)row * DM;
            f32x4 v[16]; float ss = 0.f;
#pragma unroll
            for (int c = 0; c < 8; ++c) { const v4u w = *(const v4u*)(hr + 8 * (lane + 64 * c)); v[2 * c] = (f32x4){pg8::bf_lo(w.x), pg8::bf_hi(w.x), pg8::bf_lo(w.y), pg8::bf_hi(w.y)}; v[2 * c + 1] = (f32x4){pg8::bf_lo(w.z), pg8::bf_hi(w.z), pg8::bf_lo(w.w), pg8::bf_hi(w.w)}; }
#pragma unroll
            for (int j = 0; j < 16; ++j) ss += (v[j].x * v[j].x + v[j].y * v[j].y) + (v[j].z * v[j].z + v[j].w * v[j].w);
            const float rstd = 1.0f / sqrtf(wave_sum(ss) * (1.0f / DM) + RMS_EPS);
#pragma unroll
            for (int c = 0; c < 8; ++c) { *(f32x4*)(orow + 8 * (lane + 64 * c)) = v[2 * c] * rstd * gv[2 * c]; *(f32x4*)(orow + 8 * (lane + 64 * c) + 4) = v[2 * c + 1] * rstd * gv[2 * c + 1]; }
#if DIAG_MOBA
            if (__hip_atomic_load((unsigned*)ctl + 200, RLX_AGENT) + __hip_atomic_load((unsigned*)ctl + 201, RLX_AGENT) > DIAG_MAXBAD) { const float qn = __builtin_nanf("");
#pragma unroll
                for (int c = 0; c < 16; ++c) *(f32x4*)(orow + 4 * (lane + 64 * c)) = (f32x4){qn, qn, qn, qn}; }
#endif
        }
    }
    if (PROBE_AVG >= 0) pacc_ = (unsigned long long)__hip_atomic_load(ctl0 + 210, RLX_AGENT) / gridDim.x;
    if (PROBE_PH >= 0 || PROBE_AVG >= 0) { if (PROBE_PH == PH_FINAL) pacc_ = rt() - pt0_; if (blockIdx.x == 0 && threadIdx.x == 0) { const unsigned long long te_ = rt() + 4ull * pacc_; while (rt() < te_) __builtin_amdgcn_s_sleep(20); } }
#undef IN
#undef SEAM
}

__global__ void __launch_bounds__(256) naive_attn(const bf16* __restrict__ proj, int qcol, int kcol, int vcol, int gcol, const float* __restrict__ cvec, const unsigned* __restrict__ sel, bf16* __restrict__ outb, int mode) {
    __shared__ float sq[HD]; __shared__ float sc[SEQ]; __shared__ float red[256];
    const int idx = blockIdx.x, t = idx & (SEQ - 1), h = (idx >> 13) & 7, b = idx >> 16, tid = threadIdx.x;
    const size_t row = (size_t)b * SEQ + t;
    if (tid < HD) sq[tid] = bf2f(proj[row * N1 + qcol + h * HD + tid]);
    __syncthreads();
    const unsigned mask = mode == 0 ? sel[(size_t)(b * NH + h) * SEQ + t] : 0xffffffffu;
    const float ct = mode == 1 ? cvec[(size_t)(b * NH + h) * SEQ + t] : 0.f;
    const float NEG = -__builtin_inff(); float lmax = NEG;
    for (int j = tid; j <= t; j += 256) { float s = NEG;
        if ((mask >> (j >> 8)) & 1u) { const v4u* kr = (const v4u*)(proj + ((size_t)b * SEQ + j) * N1 + kcol + h * HD); float a = 0.f;
#pragma unroll 4
            for (int i = 0; i < 16; ++i) { const v4u w = kr[i]; const float* q = sq + 8 * i;
                a += q[0] * pg8::bf_lo(w.x) + q[1] * pg8::bf_hi(w.x) + q[2] * pg8::bf_lo(w.y) + q[3] * pg8::bf_hi(w.y) + q[4] * pg8::bf_lo(w.z) + q[5] * pg8::bf_hi(w.z) + q[6] * pg8::bf_lo(w.w) + q[7] * pg8::bf_hi(w.w); }
            s = a * 0.08838834764831845f; if (mode == 1) s += ct - cvec[(size_t)(b * NH + h) * SEQ + j]; }
        sc[j] = s; lmax = fmaxf(lmax, s); }
    red[tid] = lmax; __syncthreads();
    for (int o = 128; o > 0; o >>= 1) { if (tid < o) red[tid] = fmaxf(red[tid], red[tid + o]); __syncthreads(); }
    const float mx = red[0]; __syncthreads();
    float lsum = 0.f;
    for (int j = tid; j <= t; j += 256) { const float p = expf(sc[j] - mx); sc[j] = p; lsum += p; }
    red[tid] = lsum; __syncthreads();
    for (int o = 128; o > 0; o >>= 1) { if (tid < o) red[tid] += red[tid + o]; __syncthreads(); }
    const float tot = red[0]; __syncthreads();
    const int d = tid & 127, half = tid >> 7; float acc = 0.f;
    const bf16* vb = proj + (size_t)b * SEQ * N1 + vcol + h * HD + d;
    for (int j = half; j <= t; j += 2) { const float p = sc[j]; if (p != 0.f) acc += p * bf2f(vb[(size_t)j * N1]); }
    red[tid] = acc; __syncthreads();
    if (tid < 128) { const float o = (red[tid] + red[tid + 128]) / tot; const float g = bf2f(proj[row * N1 + gcol + h * HD + tid]);
        outb[row * BW + h * HD + tid] = (bf16)f2bf(o * siluf(g)); }
}

extern "C" void kernel_launch(void* const* d_in, const int* in_sizes, int n_in, void* d_out, int out_size, void* d_ws, size_t ws_size, hipStream_t stream) {
    static int grid = 0;
    if (grid == 0) {
        if (n_in != 11 || in_sizes[0] != M * DM || out_size != M * DM || ws_size < WS_END) { fprintf(stderr, "kernel_launch: unexpected shapes (n_in %d, in0 %d, out %d, ws %zu < %zu); nothing launched\n", n_in, n_in > 0 ? in_sizes[0] : -1, out_size, ws_size, (size_t)WS_END); grid = -1; return; }
        int dev = 0, cus = 0, per_cu = 0;
        if (hipGetDevice(&dev) != hipSuccess || hipDeviceGetAttribute(&cus, hipDeviceAttributeMultiprocessorCount, dev) != hipSuccess) { grid = -1; return; }
        if (hipFuncSetAttribute((const void*)fwd, hipFuncAttributeMaxDynamicSharedMemorySize, LDS_BYTES) != hipSuccess) { fprintf(stderr, "kernel_launch: hipFuncSetAttribute failed\n"); grid = -1; return; }
        if (hipOccupancyMaxActiveBlocksPerMultiprocessor(&per_cu, (const void*)fwd, NTHR, LDS_BYTES) != hipSuccess || per_cu < 1) fprintf(stderr, "kernel_launch: occupancy query reports %d\n", per_cu);
        (void)hipGetLastError();
        grid = cus;
    }
    if (grid < 0) return;
    (void)hipMemsetAsync((char*)d_ws + WS_CTL, 0, CTL_ZERO_BYTES, stream);
    Args a{};
    for (int i = 0; i < 11; ++i) a.in[i] = (const float*)d_in[i];
    a.out = (float*)d_out; a.ws = (unsigned char*)d_ws;
    unsigned char* ws = (unsigned char*)d_ws;
    const bf16* PROJ = (const bf16*)(ws + WS_PROJ); bf16* BR = (bf16*)(ws + WS_BR);
#if ONE_LAUNCH && DIAG_MOBA == 2
    a.ph_lo = 0; a.ph_hi = 5; hipLaunchKernelGGL(fwd, dim3(grid), dim3(NTHR), LDS_BYTES, stream, a);
    hipLaunchKernelGGL(naive_attn, dim3(BATCH * NH * SEQ), dim3(256), 0, stream, (const bf16*)((unsigned char*)d_ws + WS_PROJ), A_Q, A_K, A_V, A_G, (const float*)nullptr, (const unsigned*)((unsigned char*)d_ws + WS_SEL), (bf16*)((unsigned char*)d_ws + WS_U), 0);
    (void)hipMemsetAsync((char*)d_ws + WS_CTL + CW_BAR * 4, 0, XCD_BAR_WORDS * 4, stream);
    a.ph_lo = 5; a.ph_hi = N_PHASES; hipLaunchKernelGGL(fwd, dim3(grid), dim3(NTHR), LDS_BYTES, stream, a);
#elif ONE_LAUNCH && (DIAG_MOBA == 3 || DIAG_MOBA == 4)
    a.ph_lo = 0; a.ph_hi = 5; hipLaunchKernelGGL(fwd, dim3(grid), dim3(NTHR), LDS_BYTES, stream, a);
    hipLaunchKernelGGL(naive_attn, dim3(BATCH * NH * SEQ), dim3(256), 0, stream, (const bf16*)((unsigned char*)d_ws + WS_PROJ), A_Q, A_K, A_V, A_G, (const float*)nullptr, (const unsigned*)((unsigned char*)d_ws + WS_SEL), (bf16*)((unsigned char*)d_ws + WS_U), 0);
    if (DIAG_MOBA == 4) hipLaunchKernelGGL(naive_attn, dim3(BATCH * NH * SEQ), dim3(256), 0, stream, (const bf16*)((unsigned char*)d_ws + WS_PROJ), B_Q, B_K, B_V, B_G, (const float*)((unsigned char*)d_ws + WS_C32), (const unsigned*)nullptr, (bf16*)((unsigned char*)d_ws + WS_U) + (size_t)M * BW, 1);
    (void)hipMemsetAsync((char*)d_ws + WS_CTL + CW_BAR * 4, 0, XCD_BAR_WORDS * 4, stream);
    a.ph_lo = 5; a.ph_hi = 14; hipLaunchKernelGGL(fwd, dim3(grid), dim3(NTHR), LDS_BYTES, stream, a);
    hipLaunchKernelGGL(naive_attn, dim3(BATCH * NH * SEQ), dim3(256), 0, stream, (const bf16*)((unsigned char*)d_ws + WS_PROJ), A_Q, A_K, A_V, A_G, (const float*)nullptr, (const unsigned*)((unsigned char*)d_ws + WS_SEL), (bf16*)((unsigned char*)d_ws + WS_U), 0);
    if (DIAG_MOBA == 4) hipLaunchKernelGGL(naive_attn, dim3(BATCH * NH * SEQ), dim3(256), 0, stream, (const bf16*)((unsigned char*)d_ws + WS_PROJ), B_Q, B_K, B_V, B_G, (const float*)((unsigned char*)d_ws + WS_C32), (const unsigned*)nullptr, (bf16*)((unsigned char*)d_ws + WS_U) + (size_t)M * BW, 1);
    (void)hipMemsetAsync((char*)d_ws + WS_CTL + CW_BAR * 4, 0, XCD_BAR_WORDS * 4, stream);
    a.ph_lo = 14; a.ph_hi = N_PHASES; hipLaunchKernelGGL(fwd, dim3(grid), dim3(NTHR), LDS_BYTES, stream, a);
#elif ONE_LAUNCH
    a.ph_lo = 0; a.ph_hi = N_PHASES;
    hipLaunchKernelGGL(fwd, dim3(grid), dim3(NTHR), LDS_BYTES, stream, a);
    (void)PROJ; (void)BR;
#else
    for (int ph = 0; ph < N_PHASES; ++ph) {
        const bool attn = !ATTN_IN_KERNEL && ph >= 1 && ph < PH_FINAL && ((ph - 1) % NPL) == 4;
        if (attn) {
            hipLaunchKernelGGL(naive_attn, dim3(BATCH * NH * SEQ), dim3(256), 0, stream, PROJ, A_Q, A_K, A_V, A_G, (const float*)nullptr, (const unsigned*)(ws + WS_SEL), BR, 0);
            hipLaunchKernelGGL(naive_attn, dim3(BATCH * NH * SEQ), dim3(256), 0, stream, PROJ, B_Q, B_K, B_V, B_G, (const float*)(ws + WS_C32), (const unsigned*)nullptr, BR + (size_t)M * BW, 1);
        } else {
            a.ph_lo = ph; a.ph_hi = ph + 1;
            hipLaunchKernelGGL(fwd, dim3(grid), dim3(NTHR), LDS_BYTES, stream, a);
        }
    }
#endif
}
```

```cpp
#include <hip/hip_runtime.h>
#include <cstdio>
#include <cstdint>

namespace pg8 {
#define PG8_LAS __attribute__((address_space(3)))
typedef unsigned short bf16_t;
typedef short bf16x8 __attribute__((ext_vector_type(8)));
typedef float f32x4 __attribute__((ext_vector_type(4)));
typedef unsigned u32x4 __attribute__((ext_vector_type(4)));
typedef int v4i_t __attribute__((ext_vector_type(4)));
typedef int v8i_t __attribute__((ext_vector_type(8)));
constexpr int BM = 256, BK = 64, HALF = 128, HTB = HALF * BK * 2  , STAGE_BYTES = 8 * HTB, NXCD = 8, WGM = 8;

__host__ __device__ __forceinline__ int lds_byte(int r, int c) { const int st = (r >> 4) * 2 + (c >> 5), rr = r & 15, cc = c & 31, ob = rr * 64 + cc * 2; return st * 1024 + (ob ^ (((ob >> 9) & 1) << 5)); }
__host__ __device__ __forceinline__ void stage_rc(int b, int& R, int& C) { const int st = b / 1024, sb = b % 1024, swz = sb ^ (((sb >> 9) & 1) << 5); R = (st >> 1) * 16 + swz / 64; C = (st & 1) * 32 + (swz % 64) / 2; }
__host__ __device__ __forceinline__ int perm32(int rho) { const int n = rho >> 4, i = rho & 15; return 8 * (i >> 2) + 4 * n + (i & 3); }

struct Unit { int pm, pn, z; };

struct StaticOrder {
    int nM, nN, nwg, G, c;
    __host__ __device__ void init(int M, int N, int G_, int c_) { nM = M / BM; nN = N / BM; nwg = nM * nN; G = G_; c = c_; }
    __host__ __device__ bool next(int i, Unit& u) const {
        const long L = (long)i * G + c; if (L >= nwg) return false;
        int wgid = (int)L; { const int q = nwg / NXCD, r = nwg % NXCD, xcd = wgid % NXCD, off = wgid / NXCD; wgid = (xcd < r ? xcd * (q + 1) : r * (q + 1) + (xcd - r) * q) + off; }
        const int nig = WGM * nN, gid = wgid / nig, fm = gid * WGM, gsz = (nM - fm) < WGM ? (nM - fm) : WGM;
        u.pm = fm + ((wgid % nig) % gsz); u.pn = (wgid % nig) / gsz; u.z = 0; return true;
    }
    __device__ __forceinline__ void a_ready(const Unit&) const {}
    __device__ __forceinline__ void done(const Unit&) const {}
};
struct QuadOrder {
    StaticOrder base;
    __host__ __device__ bool next(int i, Unit& u) const { if (!base.next(i >> 2, u)) return false; u.z = i & 3; return true; }
    __device__ __forceinline__ void a_ready(const Unit&) const {}
    __device__ __forceinline__ void done(const Unit&) const {}
};

struct OneTile {
    int pm, pn;
    __host__ __device__ bool next(int i, Unit& u) const { if (i) return false; u.pm = pm; u.pn = pn; u.z = 0; return true; }
    __device__ __forceinline__ void a_ready(const Unit&) const {}
    __device__ __forceinline__ void done(const Unit&) const {}
};
struct PairOrder {
    StaticOrder base;
    __host__ __device__ bool next(int i, Unit& u) const { if (!base.next(i >> 1, u)) return false; u.z = i & 1; return true; }
    __device__ __forceinline__ void a_ready(const Unit&) const {}
    __device__ __forceinline__ void done(const Unit&) const {}
};

__device__ __forceinline__ unsigned cvt_pk_bf16(float lo, float hi) { unsigned r; asm volatile("v_cvt_pk_bf16_f32 %0, %1, %2" : "=v"(r) : "v"(lo), "v"(hi)); return r; }
__device__ __forceinline__ float bf_lo(unsigned w) { return __uint_as_float(w << 16); }
__device__ __forceinline__ float bf_hi(unsigned w) { return __uint_as_float(w & 0xffff0000u); }
__device__ __forceinline__ float sigmoidf_fast(float x) { return __builtin_amdgcn_rcpf(1.0f + __builtin_amdgcn_exp2f(-1.4426950408889634f * x)); }

#ifndef F8_TILES
#define F8_TILES 0x0000000000000FFFull
#endif
constexpr unsigned long long F8T = F8_TILES;
constexpr int popc56(unsigned long long m) { int c = 0; for (int i = 0; i < 56; ++i) c += (int)((m >> i) & 1ull); return c; }
constexpr int NF8T = popc56(F8T), NBFT = 56 - NF8T;
static_assert(NF8T % 4 == 0 && (F8T & ~0x000000000FFF0FFFull) == 0ull, "fp8 tiles: whole rounds (multiples of 4), q|k|v tiles only");
__host__ __device__ __forceinline__ int nth_tile(int i, bool f8) { int c = 0; for (int t = 0; t < 56; ++t) { const bool is8 = (F8T >> t) & 1ull; if (is8 == f8) { if (c == i) return t; ++c; } } return 0; }
struct EpiStoreBf16 {
    static constexpr bool PERM = true, AFTER_DRAIN = false;
    bf16_t* O; int ldc; float asc;
    __device__ __forceinline__ void operator()(const f32x4 (&acc)[2][2][4][2], const Unit& u, int wr, int wc, int fr, int fq) const {
        const int row0 = u.pm * BM + wr * 64 + fr, col0 = u.pn * BM + wc * 32 + 8 * fq;
#pragma unroll
        for (int ai = 0; ai < 2; ++ai)
#pragma unroll
            for (int m = 0; m < 4; ++m) { bf16_t* rowp = O + (size_t)(row0 + ai * HALF + m * 16) * ldc + col0;
#pragma unroll
                for (int bj = 0; bj < 2; ++bj) { const f32x4 v0 = acc[ai][bj][m][0] * asc, v1 = acc[ai][bj][m][1] * asc;
                    u32x4 w; w.x = cvt_pk_bf16(v0[0], v0[1]); w.y = cvt_pk_bf16(v0[2], v0[3]); w.z = cvt_pk_bf16(v1[0], v1[1]); w.w = cvt_pk_bf16(v1[2], v1[3]);
                    *(u32x4*)(rowp + bj * HALF) = w; } }
    }
};
template <int MAP  > struct EpiProj {
    static constexpr bool PERM = true, AFTER_DRAIN = false;
    bf16_t* O; int ldc; float* ksum; unsigned* nrm; float asc;
    __device__ __forceinline__ void operator()(const f32x4 (&acc)[2][2][4][2], const Unit& u, int wr, int wc, int fr, int fq) const {
        const int ct = __builtin_amdgcn_readfirstlane(nth_tile(u.pn, MAP == 0));
        const int row0 = u.pm * BM + wr * 64 + fr, col0 = ct * BM + wc * 32 + 8 * fq;
#pragma unroll
        for (int ai = 0; ai < 2; ++ai)
#pragma unroll
            for (int m = 0; m < 4; ++m) { bf16_t* rowp = O + (size_t)(row0 + ai * HALF + m * 16) * ldc + col0;
#pragma unroll
                for (int bj = 0; bj < 2; ++bj) { const f32x4 v0 = acc[ai][bj][m][0] * asc, v1 = acc[ai][bj][m][1] * asc;
                    u32x4 w; w.x = cvt_pk_bf16(v0[0], v0[1]); w.y = cvt_pk_bf16(v0[2], v0[3]); w.z = cvt_pk_bf16(v1[0], v1[1]); w.w = cvt_pk_bf16(v1[2], v1[3]);
                    *(u32x4*)(rowp + bj * HALF) = w; } }
        const int pn = ct, bh0 = (u.pm >> 5) * 8;
        if (pn >= 4 && pn < 8) {
#pragma unroll
            for (int bj = 0; bj < 2; ++bj) { float cs[8];
#pragma unroll
                for (int j = 0; j < 8; ++j) { float a = 0.f;
#pragma unroll
                    for (int ai = 0; ai < 2; ++ai)
#pragma unroll
                        for (int m = 0; m < 4; ++m) a += acc[ai][bj][m][j >> 2][j & 3];
                    a += __shfl_xor(a, 1); a += __shfl_xor(a, 2); a += __shfl_xor(a, 4); a += __shfl_xor(a, 8); cs[j] = a * asc; }
                if (fr == 0) { float* dst = ksum + ((size_t)(bh0 + (pn - 4) * 2 + bj) * 32 + (u.pm & 31)) * 128 + wc * 32 + 8 * fq;
#pragma unroll
                    for (int j = 0; j < 8; ++j) atomicAdd(dst + j, cs[j]); } }
        } else if (pn >= 16 && pn < 24) {
#pragma unroll
            for (int bj = 0; bj < 2; ++bj) { float mx = 0.f;
#pragma unroll
                for (int ai = 0; ai < 2; ++ai)
#pragma unroll
                    for (int m = 0; m < 4; ++m) { const f32x4 a = acc[ai][bj][m][0], b = acc[ai][bj][m][1]; float ss = (a[0] * a[0] + a[1] * a[1]) + (a[2] * a[2] + a[3] * a[3]) + (b[0] * b[0] + b[1] * b[1]) + (b[2] * b[2] + b[3] * b[3]);
                        ss += __shfl_xor(ss, 16); ss += __shfl_xor(ss, 32); mx = fmaxf(mx, ss); }
                mx = fmaxf(mx, __shfl_xor(mx, 1)); mx = fmaxf(mx, __shfl_xor(mx, 2)); mx = fmaxf(mx, __shfl_xor(mx, 4)); mx = fmaxf(mx, __shfl_xor(mx, 8));
                if (fr == 0 && fq == 0) atomicMax(nrm + ((bh0 + (pn & 3) * 2 + bj) * 2 + (pn >= 20 ? 1 : 0)) * 4 + wc, __float_as_uint(mx * asc * asc * 1.02f)); }
        }
    }
};
struct EpiPool {
    static constexpr bool PERM = true, AFTER_DRAIN = false;
    bf16_t* O; int ldc; const float* pscale; const bf16_t* gate; int ldg;
    __device__ __forceinline__ void operator()(const f32x4 (&acc)[2][2][4][2], const Unit& u, int wr, int wc, int fr, int fq) const {
        const int row0 = u.pm * BM + wr * 64 + fr, col0 = u.pn * BM + wc * 32 + 8 * fq;
        f32x4 ps[2][2];
#pragma unroll
        for (int bj = 0; bj < 2; ++bj)
#pragma unroll
            for (int n = 0; n < 2; ++n) ps[bj][n] = *(const f32x4*)(pscale + col0 + bj * HALF + 4 * n);
#pragma unroll
        for (int ai = 0; ai < 2; ++ai)
#pragma unroll
            for (int m = 0; m < 4; ++m) { const size_t r = (size_t)(row0 + ai * HALF + m * 16);
#pragma unroll
                for (int bj = 0; bj < 2; ++bj) { const u32x4 g = *(const u32x4*)(gate + r * ldg + col0 + bj * HALF);
                    float gv[8] = {bf_lo(g.x), bf_hi(g.x), bf_lo(g.y), bf_hi(g.y), bf_lo(g.z), bf_hi(g.z), bf_lo(g.w), bf_hi(g.w)};
                    float o[8];
#pragma unroll
                    for (int j = 0; j < 8; ++j) { const float a = acc[ai][bj][m][j >> 2][j & 3] * ps[bj][j >> 2][j & 3]; o[j] = a * gv[j] * sigmoidf_fast(gv[j]); }
                    u32x4 w; w.x = cvt_pk_bf16(o[0], o[1]); w.y = cvt_pk_bf16(o[2], o[3]); w.z = cvt_pk_bf16(o[4], o[5]); w.w = cvt_pk_bf16(o[6], o[7]);
                    *(u32x4*)(O + r * ldc + col0 + bj * HALF) = w; }
                asm volatile("" ::: "memory"); }
    }
};
struct EpiMerge {
    static constexpr bool PERM = true, AFTER_DRAIN = false;
    bf16_t* P; const bf16_t* U; const float* bm; float asc;
    __device__ __forceinline__ void operator()(const f32x4 (&acc)[2][2][4][2], const Unit& u, int wr, int wc, int fr, int fq) const {
        const int row0 = u.pm * BM + wr * 64 + fr, col0 = u.pn * BM + wc * 32 + 8 * fq, z = u.z;
        const bf16_t* Uz = U + (size_t)z * 16384 * 4096;
        f32x4 bv[2][2];
#pragma unroll
        for (int bj = 0; bj < 2; ++bj)
#pragma unroll
            for (int n = 0; n < 2; ++n) bv[bj][n] = *(const f32x4*)(bm + z * 4096 + col0 + bj * HALF + 4 * n);
        u32x4 uu[3][2], pp[3][2];
#define EM_LOAD(g_, b_) do { const size_t off_ = (size_t)(row0 + ((g_) >> 2) * HALF + ((g_) & 3) * 16) * 4096 + col0; \
            uu[b_][0] = *(const u32x4*)(Uz + off_); uu[b_][1] = *(const u32x4*)(Uz + off_ + HALF); \
            if (z > 0) { pp[b_][0] = *(const u32x4*)(P + off_); pp[b_][1] = *(const u32x4*)(P + off_ + HALF); } else { pp[b_][0] = (u32x4){0u, 0u, 0u, 0u}; pp[b_][1] = (u32x4){0u, 0u, 0u, 0u}; } } while (0)
#define EM_DO(g_, b_) do { const int ai_ = (g_) >> 2, m_ = (g_) & 3; const size_t off = (size_t)(row0 + ai_ * HALF + m_ * 16) * 4096 + col0; \
            _Pragma("unroll") for (int bj = 0; bj < 2; ++bj) { const u32x4 ux = uu[b_][bj], px = pp[b_][bj]; \
                const float uv[8] = {bf_lo(ux.x), bf_hi(ux.x), bf_lo(ux.y), bf_hi(ux.y), bf_lo(ux.z), bf_hi(ux.z), bf_lo(ux.w), bf_hi(ux.w)}; \
                const float pv[8] = {bf_lo(px.x), bf_hi(px.x), bf_lo(px.y), bf_hi(px.y), bf_lo(px.z), bf_hi(px.z), bf_lo(px.w), bf_hi(px.w)}; \
                float o[8]; \
                _Pragma("unroll") for (int j = 0; j < 8; ++j) o[j] = pv[j] + sigmoidf_fast(acc[ai_][bj][m_][j >> 2][j & 3] * asc + bv[bj][j >> 2][j & 3]) * uv[j]; \
                u32x4 w; w.x = cvt_pk_bf16(o[0], o[1]); w.y = cvt_pk_bf16(o[2], o[3]); w.z = cvt_pk_bf16(o[4], o[5]); w.w = cvt_pk_bf16(o[6], o[7]); \
                *(u32x4*)(P + off + bj * HALF) = w; } } while (0)
        EM_LOAD(0, 0); EM_LOAD(1, 1); EM_LOAD(2, 2); asm volatile("" ::: "memory");
        EM_DO(0, 0); EM_DO(1, 1); EM_DO(2, 2); asm volatile("" ::: "memory");
        EM_LOAD(3, 0); EM_LOAD(4, 1); EM_LOAD(5, 2); asm volatile("" ::: "memory");
        EM_DO(3, 0); EM_DO(4, 1); EM_DO(5, 2); asm volatile("" ::: "memory");
        EM_LOAD(6, 0); EM_LOAD(7, 1); asm volatile("" ::: "memory");
        EM_DO(6, 0); EM_DO(7, 1); asm volatile("" ::: "memory");
#undef EM_DO
#undef EM_LOAD
    }
};
struct EpiMerge2 {
    static constexpr bool PERM = true, AFTER_DRAIN = false;
    bf16_t* P; const bf16_t* U; const float* bm; float asc;
    static constexpr int NKEEP = 5; mutable u32x4 keep[NKEEP];
    __device__ __forceinline__ void operator()(const f32x4 (&acc)[2][2][4][2], const Unit& u, int wr, int wc, int fr, int fq) const {
        const int row0 = u.pm * BM + wr * 64 + fr, col0 = u.pn * HALF + wc * 32 + 8 * fq, za = 2 * u.z;
        const bf16_t* Ua = U + (size_t)za * 16384 * 4096; const bf16_t* Ub = Ua + (size_t)16384 * 4096;
        f32x4 bv[2][2];
#pragma unroll
        for (int bj = 0; bj < 2; ++bj)
#pragma unroll
            for (int n = 0; n < 2; ++n) bv[bj][n] = *(const f32x4*)(bm + (za + bj) * 4096 + col0 + 4 * n);
        u32x4 ua[3], ub[3], pp[3];
#define EM_LOAD(g_, b_) do { const size_t off_ = (size_t)(row0 + ((g_) >> 2) * HALF + ((g_) & 3) * 16) * 4096 + col0; \
            ua[b_] = *(const u32x4*)(Ua + off_); ub[b_] = *(const u32x4*)(Ub + off_); \
            if ((g_) >= NKEEP) { if (za > 0) pp[(b_)] = *(const u32x4*)(P + off_); else pp[(b_)] = (u32x4){0u, 0u, 0u, 0u}; } } while (0)
#define EM_DO(g_, b_) do { const int ai_ = (g_) >> 2, m_ = (g_) & 3; const size_t off = (size_t)(row0 + ai_ * HALF + m_ * 16) * 4096 + col0; \
            const u32x4 ux = ua[b_], vx = ub[b_], px = ((g_) >= NKEEP) ? pp[(b_)] : ((za > 0) ? keep[(g_) < NKEEP ? (g_) : 0] : (u32x4){0u, 0u, 0u, 0u}); \
            const float uv[8] = {bf_lo(ux.x), bf_hi(ux.x), bf_lo(ux.y), bf_hi(ux.y), bf_lo(ux.z), bf_hi(ux.z), bf_lo(ux.w), bf_hi(ux.w)}; \
            const float vv[8] = {bf_lo(vx.x), bf_hi(vx.x), bf_lo(vx.y), bf_hi(vx.y), bf_lo(vx.z), bf_hi(vx.z), bf_lo(vx.w), bf_hi(vx.w)}; \
            const float pv[8] = {bf_lo(px.x), bf_hi(px.x), bf_lo(px.y), bf_hi(px.y), bf_lo(px.z), bf_hi(px.z), bf_lo(px.w), bf_hi(px.w)}; \
            float o[8]; \
            _Pragma("unroll") for (int j = 0; j < 8; ++j) o[j] = pv[j] + __builtin_amdgcn_rcpf(sa[0][j] * bv[0][j >> 2][j & 3] + 1.0f) * uv[j] + __builtin_amdgcn_rcpf(sb[0][j] * bv[1][j >> 2][j & 3] + 1.0f) * vv[j]; \
            u32x4 w; w.x = cvt_pk_bf16(o[0], o[1]); w.y = cvt_pk_bf16(o[2], o[3]); w.z = cvt_pk_bf16(o[4], o[5]); w.w = cvt_pk_bf16(o[6], o[7]); \
            if (za > 0 || (g_) >= NKEEP) *(u32x4*)(P + off) = w; else keep[(g_) < NKEEP ? (g_) : 0] = w; } while (0)
        const float nasc = asc * -1.4426950408889634f;
#define EM_SIG(g_, b_) do { const int ai_ = (g_) >> 2, m_ = (g_) & 3; \
            _Pragma("unroll") for (int j = 0; j < 8; ++j) { sa[b_][j] = __builtin_amdgcn_exp2f(acc[ai_][0][m_][j >> 2][j & 3] * nasc); sb[b_][j] = __builtin_amdgcn_exp2f(acc[ai_][1][m_][j >> 2][j & 3] * nasc); } \
            asm volatile("" : "+v"(sa[b_][0]), "+v"(sa[b_][1]), "+v"(sa[b_][2]), "+v"(sa[b_][3]), "+v"(sa[b_][4]), "+v"(sa[b_][5]), "+v"(sa[b_][6]), "+v"(sa[b_][7]), "+v"(sb[b_][0]), "+v"(sb[b_][1]), "+v"(sb[b_][2]), "+v"(sb[b_][3]), "+v"(sb[b_][4]), "+v"(sb[b_][5]), "+v"(sb[b_][6]), "+v"(sb[b_][7])); } while (0)
        float sa[1][8], sb[1][8];
#define EM_STEP(g_, b_) do { EM_SIG(g_, 0); __builtin_amdgcn_sched_barrier(0); EM_DO(g_, b_); if ((g_) + 3 < 8) EM_LOAD(((g_) + 3) & 7, b_); asm volatile("" ::: "memory"); __builtin_amdgcn_sched_barrier(0); } while (0)
        EM_LOAD(0, 0); EM_LOAD(1, 1); EM_LOAD(2, 2); asm volatile("" ::: "memory"); __builtin_amdgcn_sched_barrier(0);
        EM_SIG(0, 0); __builtin_amdgcn_sched_barrier(0);
#pragma unroll
        for (int bj = 0; bj < 2; ++bj)
#pragma unroll
            for (int n = 0; n < 2; ++n)
#pragma unroll
                for (int j = 0; j < 4; ++j) bv[bj][n][j] = __builtin_amdgcn_exp2f(fmaxf(bv[bj][n][j] * -1.4426950408889634f, -100.0f));
        EM_DO(0, 0); EM_LOAD(3, 0); asm volatile("" ::: "memory"); __builtin_amdgcn_sched_barrier(0);
        EM_STEP(1, 1); EM_STEP(2, 2); EM_STEP(3, 0); EM_STEP(4, 1); EM_STEP(5, 2); EM_STEP(6, 0); EM_STEP(7, 1);
#undef EM_STEP
#undef EM_SIG
#undef EM_DO
#undef EM_LOAD
    }
};
struct EpiResid {
    static constexpr bool PERM = true, AFTER_DRAIN = false;
    const float* hx; const bf16_t* hb; bf16_t* hout;
    __device__ __forceinline__ void operator()(const f32x4 (&acc)[2][2][4][2], const Unit& u, int wr, int wc, int fr, int fq) const {
        const int row0 = u.pm * BM + wr * 64 + fr, col0 = u.pn * BM + wc * 32 + 8 * fq;
        if (hx) {
            f32x4 hv[4][2][2];
#pragma unroll
            for (int ai = 0; ai < 2; ++ai) {
#pragma unroll
                for (int m = 0; m < 4; ++m) { const size_t off_ = (size_t)(row0 + ai * HALF + m * 16) * 4096 + col0;
                    hv[m][0][0] = *(const f32x4*)(hx + off_); hv[m][0][1] = *(const f32x4*)(hx + off_ + 4); hv[m][1][0] = *(const f32x4*)(hx + off_ + HALF); hv[m][1][1] = *(const f32x4*)(hx + off_ + HALF + 4); }
                asm volatile("" ::: "memory");
#pragma unroll
                for (int m = 0; m < 4; ++m) { const size_t off = (size_t)(row0 + ai * HALF + m * 16) * 4096 + col0;
#pragma unroll
                    for (int bj = 0; bj < 2; ++bj) { const f32x4 a = hv[m][bj][0] + acc[ai][bj][m][0], b = hv[m][bj][1] + acc[ai][bj][m][1];
                        u32x4 w; w.x = cvt_pk_bf16(a[0], a[1]); w.y = cvt_pk_bf16(a[2], a[3]); w.z = cvt_pk_bf16(b[0], b[1]); w.w = cvt_pk_bf16(b[2], b[3]); *(u32x4*)(hout + off + bj * HALF) = w; } }
                asm volatile("" ::: "memory"); }
        } else {
            u32x4 hv[8][2];
#pragma unroll
            for (int g = 0; g < 8; ++g) { const size_t off_ = (size_t)(row0 + (g >> 2) * HALF + (g & 3) * 16) * 4096 + col0; hv[g][0] = *(const u32x4*)(hb + off_); hv[g][1] = *(const u32x4*)(hb + off_ + HALF); }
            asm volatile("" ::: "memory");
#pragma unroll
            for (int g = 0; g < 8; ++g) { const int ai = g >> 2, m = g & 3; const size_t off = (size_t)(row0 + ai * HALF + m * 16) * 4096 + col0;
#pragma unroll
                for (int bj = 0; bj < 2; ++bj) { const u32x4 h = hv[g][bj]; const f32x4 a0 = acc[ai][bj][m][0], a1 = acc[ai][bj][m][1];
                    u32x4 w; w.x = cvt_pk_bf16(bf_lo(h.x) + a0[0], bf_hi(h.x) + a0[1]); w.y = cvt_pk_bf16(bf_lo(h.y) + a0[2], bf_hi(h.y) + a0[3]); w.z = cvt_pk_bf16(bf_lo(h.z) + a1[0], bf_hi(h.z) + a1[1]); w.w = cvt_pk_bf16(bf_lo(h.w) + a1[2], bf_hi(h.w) + a1[3]);
                    *(u32x4*)(hout + off + bj * HALF) = w; } }
        }
    }
};

template <class Epi, class Sched, class Ops, bool ALIGN_EPI, bool SP2, int FMT = 0  >
__device__ __forceinline__ void gemm_phase(PG8_LAS unsigned char* lds, const Ops& G, const Sched& S, const Epi& E) {
    int tid_ = threadIdx.x; asm volatile("" : "+v"(tid_));
    const int tid = tid_, wid = __builtin_amdgcn_readfirstlane(tid >> 6), lane = tid & 63, wr = wid >> 2, wc = wid & 3, fr = lane & 15, fq = lane >> 4;
    const int K = G.K, nt = K / BK;
    unsigned voffA[2], voffB[2];
#pragma unroll
    for (int i = 0; i < 2; ++i) { int R, C; stage_rc(tid * 16 + i * 8192, R, C); const int Rb = Epi::PERM ? ((R & ~31) + perm32(R & 31)) : R;
        voffA[i] = (unsigned)(R * G.lda + C) * 2u; voffB[i] = (unsigned)(Rb * G.ldb + C) * 2u; }
    const size_t kstep = (size_t)(BK * 2);
    const size_t hstepA = (size_t)HALF * G.lda * 2, hstepB = G.hsb();
    const unsigned ldsw = (unsigned)wid * 1024u;
    const int aoff = lds_byte(wr * 64 + fr, fq * 8), boff = lds_byte(wc * 32 + fr, fq * 8);
#define PG8_SA(b, h) (((b) * 2 + (h)) * HTB)
#define PG8_SB(b, h) ((4 + (b) * 2 + (h)) * HTB)
#define PG8_STAGE(bufoff, gbase, voff) do { _Pragma("unroll") for (int _i = 0; _i < 2; ++_i) \
        __builtin_amdgcn_global_load_lds((const unsigned*)((const char*)(gbase) + (voff)[_i]), (PG8_LAS unsigned*)(lds + (bufoff) + ldsw + _i * 8192), 16, 0, 0); } while (0)
#define PG8_LDA(dst, b, h) do { _Pragma("unroll") for (int m = 0; m < 4; ++m) { \
        if constexpr (FMT == 0) { _Pragma("unroll") for (int k = 0; k < 2; ++k) dst[m][k] = *(const PG8_LAS bf16x8*)(lds + PG8_SA(b, h) + aoff + m * 2048 + k * 1024); } \
        else { const v4i_t lo_ = *(const PG8_LAS v4i_t*)(lds + PG8_SA(b, h) + aoff + m * 2048), hi_ = *(const PG8_LAS v4i_t*)(lds + PG8_SA(b, h) + aoff + m * 2048 + 1024); dst##8[m] = __builtin_shufflevector(lo_, hi_, 0, 1, 2, 3, 4, 5, 6, 7); } } } while (0)
#define PG8_LDB(dst, b, h) do { _Pragma("unroll") for (int n = 0; n < 2; ++n) { \
        if constexpr (FMT == 0) { _Pragma("unroll") for (int k = 0; k < 2; ++k) dst[n][k] = *(const PG8_LAS bf16x8*)(lds + PG8_SB(b, h) + boff + n * 2048 + k * 1024); } \
        else { const v4i_t lo_ = *(const PG8_LAS v4i_t*)(lds + PG8_SB(b, h) + boff + n * 2048), hi_ = *(const PG8_LAS v4i_t*)(lds + PG8_SB(b, h) + boff + n * 2048 + 1024); dst##8[n] = __builtin_shufflevector(lo_, hi_, 0, 1, 2, 3, 4, 5, 6, 7); } } } while (0)
#define PG8_MMA(ai, bj, At, Bt) do { __builtin_amdgcn_s_setprio(1); _Pragma("unroll") for (int m = 0; m < 4; ++m) _Pragma("unroll") for (int n = 0; n < 2; ++n) { \
        if constexpr (FMT == 0) { _Pragma("unroll") for (int k = 0; k < 2; ++k) acc[ai][bj][m][n] = __builtin_amdgcn_mfma_f32_16x16x32_bf16(Bt[n][k], At[m][k], acc[ai][bj][m][n], 0, 0, 0); } \
        else {   \
            asm volatile("v_mfma_scale_f32_16x16x128_f8f6f4 %0, %1, %2, %0, %3, %3 op_sel_hi:[0,0,0]" : "+v"(acc[ai][bj][m][n]) : "v"(Bt##8[n]), "v"(At##8[m]), "v"(sc1_)); } }   \
        __builtin_amdgcn_s_setprio(0); } while (0)
#define PG8_WAIT_V(n) asm volatile("s_waitcnt vmcnt(" #n ")" ::: "memory")
#define PG8_WAIT_L(n) asm volatile("s_waitcnt lgkmcnt(" #n ")" ::: "memory")
#define PG8_BAR __builtin_amdgcn_s_barrier()
#define PG8_SCHED __builtin_amdgcn_sched_barrier(0)
    Unit cur, nxt; int ui = 0;
    if (!S.next(0, cur)) return;
    f32x4 acc[2][2][4][2];
#pragma unroll
    for (int a = 0; a < 2; ++a)
#pragma unroll
        for (int b = 0; b < 2; ++b)
#pragma unroll
            for (int m = 0; m < 4; ++m)
#pragma unroll
                for (int n = 0; n < 2; ++n) acc[a][b][m][n] = (f32x4){0.f, 0.f, 0.f, 0.f};
    bf16x8 At[4][2], B0[2][2], B1[2][2];
    const int sc1_ = 0x7f7f7f7f;
    v8i_t At8[4], B08[2], B18[2];
    (void)At; (void)B0; (void)B1; (void)At8; (void)B08; (void)B18; (void)sc1_;
    const char* cA = G.a_ptr(cur); const char* cB = G.b_ptr(cur);
    S.a_ready(cur);
    if constexpr (SP2) {
        PG8_STAGE(PG8_SB(0, 0), cB, voffB); PG8_STAGE(PG8_SB(0, 1), cB + hstepB, voffB); PG8_STAGE(PG8_SA(0, 0), cA, voffA); PG8_STAGE(PG8_SA(0, 1), cA + hstepA, voffA);
        if (wr == 1) PG8_BAR;
        PG8_WAIT_V(2); PG8_BAR;
        PG8_STAGE(PG8_SB(1, 0), cB + kstep, voffB); PG8_STAGE(PG8_SA(1, 0), cA + kstep, voffA); PG8_STAGE(PG8_SB(1, 1), cB + hstepB + kstep, voffB);
        PG8_WAIT_V(6); PG8_BAR;
    } else {
        PG8_STAGE(PG8_SB(0, 0), cB, voffB); PG8_STAGE(PG8_SA(0, 0), cA, voffA); PG8_STAGE(PG8_SB(0, 1), cB + hstepB, voffB); PG8_STAGE(PG8_SA(0, 1), cA + hstepA, voffA);
        if (wr == 1) PG8_BAR;
        PG8_WAIT_V(4); PG8_BAR;
        PG8_STAGE(PG8_SB(1, 0), cB + kstep, voffB); PG8_STAGE(PG8_SA(1, 0), cA + kstep, voffA); PG8_STAGE(PG8_SB(1, 1), cB + hstepB + kstep, voffB);
        PG8_WAIT_V(6); PG8_BAR;
    }
    for (;;) {
        const bool has_next = S.next(ui + 1, nxt);
        const char* nA = has_next ? G.a_ptr(nxt) : cA; const char* nB = has_next ? G.b_ptr(nxt) : cB;
        for (int t = 0; t < nt; t += 2) {
            const bool last = (t == nt - 2);
            const char* a1 = cA + (size_t)(t + 1) * kstep;
            const char* a2 = last ? nA : cA + (size_t)(t + 2) * kstep; const char* b2 = last ? nB : cB + (size_t)(t + 2) * kstep;
            const char* a3 = a2 + kstep; const char* b3 = b2 + kstep;
            if (last && has_next) S.a_ready(nxt);
            if constexpr (SP2) {
            PG8_LDB(B0, 0, 0); PG8_LDB(B1, 0, 1); PG8_SCHED; PG8_LDA(At, 0, 0); PG8_STAGE(PG8_SA(1, 1), a1 + hstepA, voffA);
            PG8_WAIT_V(8); PG8_WAIT_L(0); PG8_BAR; PG8_MMA(0, 0, At, B0); PG8_MMA(0, 1, At, B1); PG8_BAR; PG8_SCHED;
            PG8_LDA(At, 0, 1); PG8_STAGE(PG8_SB(0, 0), b2, voffB); PG8_STAGE(PG8_SB(0, 1), b2 + hstepB, voffB); PG8_STAGE(PG8_SA(0, 0), a2, voffA);
            PG8_WAIT_V(8); PG8_WAIT_L(0); PG8_BAR; PG8_MMA(1, 0, At, B0); PG8_MMA(1, 1, At, B1); PG8_BAR; PG8_SCHED;
            PG8_LDB(B0, 1, 0); PG8_LDB(B1, 1, 1); PG8_SCHED; PG8_LDA(At, 1, 0); PG8_STAGE(PG8_SA(0, 1), a2 + hstepA, voffA);
            PG8_WAIT_V(8); PG8_WAIT_L(0); PG8_BAR; PG8_MMA(0, 0, At, B0); PG8_MMA(0, 1, At, B1); PG8_BAR; PG8_SCHED;
            PG8_LDA(At, 1, 1); PG8_STAGE(PG8_SB(1, 0), b3, voffB); PG8_STAGE(PG8_SB(1, 1), b3 + hstepB, voffB); PG8_STAGE(PG8_SA(1, 0), a3, voffA);
            PG8_WAIT_V(8); PG8_WAIT_L(0); PG8_BAR; PG8_MMA(1, 0, At, B0); PG8_MMA(1, 1, At, B1); PG8_BAR; PG8_SCHED;
            } else {
            PG8_LDB(B0, 0, 0); PG8_SCHED; PG8_LDA(At, 0, 0); PG8_STAGE(PG8_SA(1, 1), a1 + hstepA, voffA);
            PG8_WAIT_L(8); PG8_BAR; PG8_WAIT_L(0); PG8_MMA(0, 0, At, B0); PG8_BAR; PG8_SCHED;
            PG8_LDB(B1, 0, 1); PG8_STAGE(PG8_SB(0, 0), b2, voffB);
            PG8_BAR; PG8_WAIT_L(0); PG8_MMA(0, 1, At, B1); PG8_BAR;
            PG8_LDA(At, 0, 1); PG8_STAGE(PG8_SA(0, 0), a2, voffA);
            PG8_BAR; PG8_WAIT_L(0); PG8_MMA(1, 0, At, B0); PG8_BAR; PG8_SCHED;
            PG8_STAGE(PG8_SB(0, 1), b2 + hstepB, voffB);
            PG8_WAIT_V(6); PG8_BAR; PG8_MMA(1, 1, At, B1); PG8_BAR;
            PG8_LDB(B0, 1, 0); PG8_SCHED; PG8_LDA(At, 1, 0); PG8_STAGE(PG8_SA(0, 1), a2 + hstepA, voffA);
            PG8_WAIT_L(8); PG8_BAR; PG8_WAIT_L(0); PG8_MMA(0, 0, At, B0); PG8_BAR; PG8_SCHED;
            PG8_LDB(B1, 1, 1); PG8_STAGE(PG8_SB(1, 0), b3, voffB);
            PG8_BAR; PG8_WAIT_L(0); PG8_MMA(0, 1, At, B1); PG8_BAR;
            PG8_LDA(At, 1, 1); PG8_STAGE(PG8_SA(1, 0), a3, voffA);
            PG8_BAR; PG8_WAIT_L(0); PG8_MMA(1, 0, At, B0); PG8_BAR; PG8_SCHED;
            PG8_STAGE(PG8_SB(1, 1), b3 + hstepB, voffB);
            PG8_WAIT_V(6); PG8_BAR; PG8_MMA(1, 1, At, B1); PG8_BAR;
            }
        }
        if constexpr (ALIGN_EPI) { if (wr == 0) PG8_BAR; }
        if constexpr (!Epi::AFTER_DRAIN) { E(acc, cur, wr, wc, fr, fq); S.done(cur); }
        if (!has_next) break;
#pragma unroll
        for (int a = 0; a < 2; ++a)
#pragma unroll
            for (int b = 0; b < 2; ++b)
#pragma unroll
                for (int m = 0; m < 4; ++m)
#pragma unroll
                    for (int n = 0; n < 2; ++n) acc[a][b][m][n] = (f32x4){0.f, 0.f, 0.f, 0.f};
        cur = nxt; cA = nA; cB = nB; ++ui;
        if constexpr (ALIGN_EPI) { if (wr == 1) PG8_BAR; }
    }
    PG8_WAIT_V(0);
    if constexpr (!ALIGN_EPI) { if (wr == 0) PG8_BAR; }
    PG8_BAR;
    if constexpr (Epi::AFTER_DRAIN) { E.fused(acc, cur, wr, wc, fr, fq, lds, wid, lane); S.done(cur); }
#undef PG8_SA
#undef PG8_SB
#undef PG8_STAGE
#undef PG8_LDA
#undef PG8_LDB
#undef PG8_MMA
#undef PG8_WAIT_V
#undef PG8_WAIT_L
#undef PG8_BAR
#undef PG8_SCHED
}
}
#define GAS __attribute__((address_space(1)))
#define LAS __attribute__((address_space(3)))
typedef unsigned short bf16;
typedef unsigned v4u __attribute__((ext_vector_type(4)));
typedef float f32x4 __attribute__((ext_vector_type(4)));
typedef short bf16x8 __attribute__((ext_vector_type(8)));
typedef GAS unsigned gu32;
typedef GAS unsigned long long gu64;
#define RLX_AGENT __ATOMIC_RELAXED, __HIP_MEMORY_SCOPE_AGENT
#define LDS_WAIT() asm volatile("s_waitcnt lgkmcnt(0)" ::: "memory")
#define VM_WAIT() asm volatile("s_waitcnt vmcnt(0)" ::: "memory")
__device__ __forceinline__ unsigned long long rt() { return __builtin_amdgcn_s_memrealtime(); }
__device__ __forceinline__ unsigned f2bf(float f) { unsigned u = __builtin_bit_cast(unsigned, f); return (u + 0x7fffu + ((u >> 16) & 1u)) >> 16; }
__device__ __forceinline__ unsigned pk2(float lo, float hi) { return f2bf(lo) | (f2bf(hi) << 16); }

#define XB_TMO      128
#define XB_XCNT(j)  (256  + 64 * (j))
#define XB_XSUB(j)  (1280 + 64 * (j))
#define XB_XGEN(j)  (2304 + 64 * (j))
#define XB_TOP      3328
#define XB_TOPGEN   3392
#define XCD_BAR_WORDS 3456
#define XB_SPIN_CAP (1u << 18)

__device__ __forceinline__ unsigned xb_ld(unsigned* p)              { return __hip_atomic_load(p, __ATOMIC_RELAXED, __HIP_MEMORY_SCOPE_AGENT); }
__device__ __forceinline__ unsigned xb_add(unsigned* p, unsigned v) { return __hip_atomic_fetch_add(p, v, __ATOMIC_RELAXED, __HIP_MEMORY_SCOPE_AGENT); }
__device__ __forceinline__ unsigned xb_xcc_id() { return (unsigned)__builtin_amdgcn_s_getreg((3 << 11) | 20) & 0xFu; }
#define XB_SPIN(cond, bar) do { unsigned _sp = 0; while (cond) { __builtin_amdgcn_s_sleep(1); \
    if ((++_sp & 255u) == 0u) { if (xb_ld(&(bar)[XB_TMO])) break; if (_sp > XB_SPIN_CAP) { atomicAdd(&(bar)[XB_TMO], 1u); break; } } } } while (0)

struct XcdBarrier {
    unsigned* bar; unsigned x;
    volatile LAS unsigned* st;
};

__device__ __forceinline__ XcdBarrier xcd_barrier_post(unsigned* bar, volatile LAS unsigned* st) {
    XcdBarrier b; b.bar = bar; b.x = xb_xcc_id(); b.st = st;
    if (threadIdx.x == 0) (void)xb_add(&bar[XB_XCNT(b.x)], 1u);
    return b;
}
__device__ __forceinline__ void xcd_barrier_complete(unsigned* bar, unsigned x, unsigned& nloc, unsigned& nx) {
    const unsigned G = gridDim.x * gridDim.y * gridDim.z;
    unsigned sum, cnt, mine, sp = 0u;
    for (;;) {
        sum = 0u; cnt = 0u; mine = 0u;
#pragma unroll
        for (unsigned j = 0; j < 16; ++j) { const unsigned c = xb_ld(&bar[XB_XCNT(j)]); sum += c; cnt += (c > 0u) ? 1u : 0u; mine = (j == x) ? c : mine; }
        if (sum == G) break;
        __builtin_amdgcn_s_sleep(1);
        if ((++sp & 255u) == 0u) { if (xb_ld(&bar[XB_TMO])) break; if (sp > XB_SPIN_CAP) { atomicAdd(&bar[XB_TMO], 1u); break; } }
    }
    nloc = mine > 0u ? mine : 1u; nx = cnt > 0u ? cnt : 1u;
}

__device__ __forceinline__ void xcd_barrier(const XcdBarrier& b) {
    asm volatile("s_waitcnt vmcnt(0)" ::: "memory");
    __syncthreads();
    if (threadIdx.x == 0) {
        unsigned* bar = b.bar;
        __builtin_amdgcn_s_waitcnt(0);
        unsigned nloc = b.st[0], nx = b.st[1];
        if (nloc == 0u) { xcd_barrier_complete(bar, b.x, nloc, nx); b.st[0] = nloc; b.st[1] = nx; }
        const unsigned old = xb_add(&bar[XB_XSUB(b.x)], 1u);
        const unsigned gen = old / nloc;
        if (old + 1u == (gen + 1u) * nloc) {
            __builtin_amdgcn_fence(__ATOMIC_RELEASE, "agent");
            asm volatile("s_waitcnt vmcnt(0)" ::: "memory");
            const unsigned og = xb_add(&bar[XB_TOP], 1u);
            const unsigned tg = og / nx;
            if (og + 1u == (tg + 1u) * nx) xb_add(&bar[XB_TOPGEN], 1u);
            else XB_SPIN(xb_ld(&bar[XB_TOPGEN]) == tg, bar);
            __builtin_amdgcn_fence(__ATOMIC_ACQUIRE, "agent");
            xb_add(&bar[XB_XGEN(b.x)], 1u);
            asm volatile("s_waitcnt vmcnt(0)" ::: "memory");
        } else {
            XB_SPIN(xb_ld(&bar[XB_XGEN(b.x)]) == gen, bar);
            __builtin_amdgcn_fence(__ATOMIC_ACQUIRE, "agent");
            asm volatile("s_waitcnt vmcnt(0)" ::: "memory");
        }
    }
    __syncthreads();
}

#ifndef DIAG_MOBA
#define DIAG_MOBA 0
#endif
#ifndef DIAG_TOL
#define DIAG_TOL 0.03f
#endif
#ifndef DIAG_MAXBAD
#define DIAG_MAXBAD 2000u
#endif
namespace att {
typedef short s16x4 __attribute__((ext_vector_type(4)));
typedef float f32x16 __attribute__((ext_vector_type(16)));
typedef unsigned u32x4 __attribute__((ext_vector_type(4)));
constexpr int D = 128, NW = 8, QBLK = 32, KVBLK = 64, QB = NW * QBLK;
constexpr int SHM_V = KVBLK * D * 2, SHM_K = KVBLK * D * 2;
constexpr int OFF_K = 2 * SHM_V, OFF_WS = 2 * SHM_V + 2 * SHM_K, OFF_BIAS = OFF_WS + NW * 96 * 4, LDS_ATT = OFF_BIAS + 2 * 1024;
constexpr float SCALE = 0.08838834764831845f, THR = 8.f;
constexpr int LDI = 14336, LDO = 1024;
#define KSWZ(row, colB) ((row) * 256 + ((colB) ^ (((row) & 7) << 4)))
#define SBAR() __builtin_amdgcn_sched_barrier(0)
__device__ __forceinline__ int v_st(int k, int c) { const int kk = (k & ~0xC) | ((k & 4) << 1) | ((k & 8) >> 1); return ((kk >> 3) * 4 + (c >> 5)) * 512 + ((kk & 7) * 32 + (c & 31)) * 2; }
__device__ __forceinline__ int v_rd_base(int lane) { return ((lane & 3) << 3) | (((lane >> 2) & 3) << 6) | (((lane >> 4) & 1) << 5) | (((lane >> 5) & 1) << 8); }
constexpr int v_rd_off(int d0, int ks, int half) { return d0 * 512 + ks * 4096 + half * 2048; }
__device__ __forceinline__ int crow(int r, int hi) { return (r & 3) + 8 * (r >> 2) + 4 * hi; }
__device__ __forceinline__ unsigned cvtpk(float lo, float hi) { unsigned r; asm volatile("v_cvt_pk_bf16_f32 %0, %1, %2" : "=v"(r) : "v"(lo), "v"(hi)); return r; }
__device__ __forceinline__ bf16x8 load8(const bf16* p) { return *reinterpret_cast<const bf16x8*>(p); }
__device__ __forceinline__ void mask_tile(f32x16& p0, f32x16& p1, int dq) {
    const float NEG = -__builtin_inff();
#pragma unroll
    for (int r = 0; r < 16; ++r) { const int c = (r & 3) + 8 * (r >> 2); if (dq - c < 0) p0[r] = NEG; if (dq - c - 32 < 0) p1[r] = NEG; }
}
template <bool DEFER>
__device__ __forceinline__ void partialSM(f32x16& p0, f32x16& p1, float& m_reg, float& mn, float& alpha) {
    float pmax = p0[0]; for (int r = 1; r < 16; ++r) pmax = fmaxf(pmax, p0[r]); for (int r = 0; r < 16; ++r) pmax = fmaxf(pmax, p1[r]);
    { auto rr = __builtin_amdgcn_permlane32_swap(__float_as_uint(pmax), __float_as_uint(pmax), false, false);
      pmax = fmaxf(__uint_as_float(rr[0]), __uint_as_float(rr[1])); }
    constexpr float C2 = 1.4426950408889634f * SCALE;
    if (DEFER && __builtin_expect(__all((pmax - m_reg) * SCALE <= THR), 1)) { mn = m_reg; alpha = 1.f; }
    else { mn = fmaxf(m_reg, pmax); alpha = __builtin_amdgcn_exp2f((m_reg - mn) * C2); m_reg = mn; }
    const float mnL = -mn * C2;
    for (int r = 0; r < 16; ++r) p0[r] = fmaf(p0[r], C2, mnL); for (int r = 0; r < 16; ++r) p1[r] = fmaf(p1[r], C2, mnL);
    for (int r = 0; r < 16; ++r) p0[r] = __builtin_amdgcn_exp2f(p0[r]);
}
__device__ __forceinline__ void finishSM(f32x16& p0, f32x16& p1, float alpha, float& l_reg, bf16x8& pa0, bf16x8& pa1, bf16x8& pa2, bf16x8& pa3) {
    for (int r = 0; r < 16; ++r) p1[r] = __builtin_amdgcn_exp2f(p1[r]);
    float ps = 0; for (int r = 0; r < 16; ++r) ps += p0[r]; for (int r = 0; r < 16; ++r) ps += p1[r];
    { auto rr = __builtin_amdgcn_permlane32_swap(__float_as_uint(ps), __float_as_uint(ps), false, false);
      ps = __uint_as_float(rr[0]) + __uint_as_float(rr[1]); }
    l_reg = l_reg * alpha + ps;
#define PK4(P, B_, OUT) do { unsigned a0 = cvtpk(P[B_+0], P[B_+1]), a1 = cvtpk(P[B_+2], P[B_+3]);                          \
        unsigned b0 = cvtpk(P[B_+4], P[B_+5]), b1 = cvtpk(P[B_+6], P[B_+7]);                                             \
        auto r0 = __builtin_amdgcn_permlane32_swap(a0, b0, false, false); auto r1 = __builtin_amdgcn_permlane32_swap(a1, b1, false, false); \
        u32x4 w = {r0[0], r1[0], r0[1], r1[1]}; OUT = *reinterpret_cast<bf16x8*>(&w); } while (0)
    PK4(p0, 0, pa0); PK4(p0, 8, pa1); PK4(p1, 0, pa2); PK4(p1, 8, pa3);
#undef PK4
}
template <int KB, int MODE>
__device__ __forceinline__ void qkt(f32x16& p0, f32x16& p1, const char* K_lds, const char* B_lds, int r32, int hi, const bf16x8* qr) {
    p0 = f32x16{}; p1 = f32x16{};
    const char* kb[4];
#pragma unroll
    for (int dd = 0; dd < 4; ++dd) kb[dd] = K_lds + KB * SHM_K + KSWZ(r32, (dd * 16 + hi * 8) * 2);
#pragma unroll
    for (int d0 = 0; d0 < 8; ++d0) { const char* a = kb[d0 & 3] + (d0 >> 2) * 128;
        bf16x8 b0 = *reinterpret_cast<const bf16x8*>(a);
        bf16x8 b1 = *reinterpret_cast<const bf16x8*>(a + 32 * 256);
        p0 = __builtin_amdgcn_mfma_f32_32x32x16_bf16(b0, qr[d0], p0, 0, 0, 0);
        p1 = __builtin_amdgcn_mfma_f32_32x32x16_bf16(b1, qr[d0], p1, 0, 0, 0); }
    if (MODE == 1) { const unsigned one2 = hi ? 0u : 0x3f803f80u, one1 = hi ? 0u : 0x00003f80u; const u32x4 qw = {one2, one1, 0u, 0u}; const bf16x8 qx = *reinterpret_cast<const bf16x8*>(&qw);
        const bf16x8 e0 = *reinterpret_cast<const bf16x8*>(B_lds + KB * 1024 + r32 * 16), e1 = *reinterpret_cast<const bf16x8*>(B_lds + KB * 1024 + 512 + r32 * 16);
        p0 = __builtin_amdgcn_mfma_f32_32x32x16_bf16(e0, qx, p0, 0, 0, 0);
        p1 = __builtin_amdgcn_mfma_f32_32x32x16_bf16(e1, qx, p1, 0, 0, 0); }
}
template <int VB>
__device__ __forceinline__ void pv_tile(f32x16* o, int vb0, bf16x8 pa0, bf16x8 pa1, bf16x8 pa2, bf16x8 pa3) {
#define TRRD(dst, off) asm volatile("ds_read_b64_tr_b16 %0, %1 offset:%2" : "=&v"(dst) : "v"(vb0), "i"(off) : "memory")
#define PV_D0(d0) do { s16x4 l0, l1, l2, l3, h0, h1, h2, h3; constexpr int b_ = VB * SHM_V + v_rd_off(d0, 0, 0); \
        TRRD(l0, b_); TRRD(h0, b_ + 2048); TRRD(l1, b_ + 4096); TRRD(h1, b_ + 6144); TRRD(l2, b_ + 8192); TRRD(h2, b_ + 10240); TRRD(l3, b_ + 12288); TRRD(h3, b_ + 14336); \
        asm volatile("s_waitcnt lgkmcnt(0)" ::: "memory"); SBAR(); \
        o[d0] = __builtin_amdgcn_mfma_f32_32x32x16_bf16(pa0, (bf16x8){l0[0], l0[1], l0[2], l0[3], h0[0], h0[1], h0[2], h0[3]}, o[d0], 0, 0, 0);   \
        o[d0] = __builtin_amdgcn_mfma_f32_32x32x16_bf16(pa1, (bf16x8){l1[0], l1[1], l1[2], l1[3], h1[0], h1[1], h1[2], h1[3]}, o[d0], 0, 0, 0);   \
        o[d0] = __builtin_amdgcn_mfma_f32_32x32x16_bf16(pa2, (bf16x8){l2[0], l2[1], l2[2], l2[3], h2[0], h2[1], h2[2], h2[3]}, o[d0], 0, 0, 0);   \
        o[d0] = __builtin_amdgcn_mfma_f32_32x32x16_bf16(pa3, (bf16x8){l3[0], l3[1], l3[2], l3[3], h3[0], h3[1], h3[2], h3[3]}, o[d0], 0, 0, 0); } while (0)
    PV_D0(0); PV_D0(1); PV_D0(2); PV_D0(3);
#undef PV_D0
#undef TRRD
}

struct Bases { const bf16* proj; bf16* br; const v4u* bias; const unsigned* sel; const unsigned* lists; bf16* part; float* ml; };
struct BlockRef { int bh, qb, j0, kind, lbase, nval; };
template <int MODE> struct Ptrs {
    static __device__ __forceinline__ const bf16* hb(const Bases& B, const BlockRef& R) { return B.proj + (size_t)((unsigned)(R.bh >> 3) * 8192u) * LDI + (unsigned)((R.bh & 7) * 128 + (MODE == 1 ? 4096 : 0)); }
    static __device__ __forceinline__ const bf16* Q(const Bases& B, const BlockRef& R) { return hb(B, R) + (size_t)((unsigned)R.qb * 256u) * LDI; }
    static __device__ __forceinline__ const bf16* K(const Bases& B, const BlockRef& R) { return hb(B, R) + 1024; }
    static __device__ __forceinline__ const bf16* V(const Bases& B, const BlockRef& R) { return hb(B, R) + 2048; }
    static __device__ __forceinline__ const bf16* Gt(const Bases& B, const BlockRef& R) { return hb(B, R) + (size_t)((unsigned)R.qb * 256u) * LDI + 3072; }
    static __device__ __forceinline__ bf16* O(const Bases& B, const BlockRef& R) { return B.br + ((size_t)(MODE == 1 ? 1 : 0) * 16384 + (size_t)((unsigned)(R.bh >> 3) * 8192u + (unsigned)R.qb * 256u)) * LDO + (unsigned)((R.bh & 7) * 128); }
    static __device__ __forceinline__ const v4u* Bias(const Bases& B, const BlockRef& R) { return B.bias + (size_t)((unsigned)R.bh * 8192u); }
    static __device__ __forceinline__ const unsigned* Sel(const Bases& B, const BlockRef& R) { return B.sel + (size_t)((unsigned)R.bh * 8192u + (unsigned)R.qb * 256u); }
};
struct Seam { bf16x8 qr[8]; bf16x8 st_v0, st_v1, st_k0, st_k1; v4u st_b; unsigned selr; };
#define ROW(p, k0, rr) ((p) + (size_t)(((unsigned)(k0) + (unsigned)(rr)) * (unsigned)LDI + (unsigned)sc))
#define VMW() asm volatile("s_waitcnt vmcnt(0)" ::: "memory")
#define VMWN(n) asm volatile("s_waitcnt vmcnt(%0)" :: "i"(n) : "memory")
#define SLOAD_H(R_, k0) do { const bf16* Vp_ = Ptrs<MODE>::V(BS, R_); const bf16* Kp_ = Ptrs<MODE>::K(BS, R_); S.st_v0 = load8(ROW(Vp_, k0, sr)); S.st_v1 = load8(ROW(Vp_, k0, 32 + sr));              \
                         S.st_k0 = load8(ROW(Kp_, k0, sr)); S.st_k1 = load8(ROW(Kp_, k0, 32 + sr)); if (MODE == 1 && tid < 64) S.st_b = Ptrs<MODE>::Bias(BS, R_)[(unsigned)(k0) + (unsigned)tid]; } while (0)
#define SWRITE_HK(bf) do { *(bf16x8*)(K_lds + (bf) * SHM_K + kws) = S.st_k0; *(bf16x8*)(K_lds + (bf) * SHM_K + kws + 32 * 256) = S.st_k1; if (MODE == 1 && tid < 64) *(v4u*)(B_lds + (bf) * 1024 + tid * 16) = S.st_b; } while (0)
#define SWRITE_HV(bf) do { *(bf16x8*)(V_lds + (bf) * SHM_V + vst0) = S.st_v0; *(bf16x8*)(V_lds + (bf) * SHM_V + vst1) = S.st_v1; } while (0)
#define SWRITE_H(bf) do { SWRITE_HV(bf); SWRITE_HK(bf); } while (0)
__device__ __forceinline__ unsigned row_entry(const Bases& B, const BlockRef& R, int i) {
    if (R.kind == 0) return (unsigned)(R.qb * 256 + i) | (3u << 16) | 0x80000000u;
    const bool v = i < R.nval; return B.lists[(unsigned)R.lbase + (unsigned)(v ? i : 0)] | (v ? 0x80000000u : 0u);
}
template <int MODE>
__device__ __forceinline__ void attn_prime(const Bases& BS, const BlockRef& cur, char* lds, Seam& S) {
    int tid_ = threadIdx.x; asm volatile("" : "+v"(tid_));
    const int tid = tid_, wid = __builtin_amdgcn_readfirstlane(tid >> 6), lane = tid & 63, r32 = lane & 31, hi = lane >> 5;
    const int sr = tid >> 4, sc = (tid & 15) * 8, kws = KSWZ(sr, sc * 2); char* K_lds = lds + OFF_K; char* B_lds = lds + OFF_BIAS;
    if (MODE == 2) { S.selr = row_entry(BS, cur, wid * QBLK + r32); const bf16* qrow = Ptrs<MODE>::hb(BS, cur) + (size_t)((S.selr & 0xffffu) * (unsigned)LDI);
#pragma unroll
        for (int d0 = 0; d0 < 8; ++d0) S.qr[d0] = load8(qrow + (unsigned)(d0 * 16 + hi * 8)); }
    else {
#pragma unroll
    for (int d0 = 0; d0 < 8; ++d0) S.qr[d0] = load8(Ptrs<MODE>::Q(BS, cur) + (size_t)((unsigned)(wid * QBLK + r32) * (unsigned)LDI + (unsigned)(d0 * 16 + hi * 8)));
    if (MODE == 0) S.selr = Ptrs<MODE>::Sel(BS, cur)[(unsigned)(wid * QBLK + r32)]; }
    SLOAD_H(cur, cur.j0 * KVBLK); VMW(); SWRITE_HK(0);
    __syncthreads();
}
template <int MODE>
__device__ __forceinline__ void attn_block(const Bases& BS, const BlockRef& cur, const BlockRef& nxt, char* lds, Seam& S) {
    int tid_ = threadIdx.x; asm volatile("" : "+v"(tid_));
    const int tid = tid_, wid = __builtin_amdgcn_readfirstlane(tid >> 6), lane = tid & 63, r32 = lane & 31, hi = lane >> 5;
    const int P0 = cur.qb * QB, j0 = cur.j0, NT = (MODE == 2) ? 4 : (P0 + QB - 1) / KVBLK + 1 - j0;
    const int qlo = P0 + wid * QBLK, qm = qlo + r32 - 4 * hi;
    char* V_lds = lds; char* K_lds = lds + OFF_K; char* B_lds = lds + OFF_BIAS;
    float* ws = (float*)(lds + OFF_WS) + wid * 96; float* li_l = ws, * al_l = ws + 32;
    float m_reg = -1e30f, l_reg = 0; f32x16 o[4] = {};
    const int sr = tid >> 4, sc = (tid & 15) * 8, vst0 = v_st(sr, sc), vst1 = v_st(32 + sr, sc), kws = KSWZ(sr, sc * 2);
    const int vb0 = (int)(uintptr_t)V_lds + v_rd_base(lane);
    const unsigned selr = S.selr;
    unsigned* rowtab = (unsigned*)ws + 64;
    unsigned entn = 0u; if (MODE == 2) { if (hi == 0) rowtab[r32] = selr; entn = row_entry(BS, nxt, wid * QBLK + r32); }
#define RESC(a) do { if (__any((a) < 1.f)) { if (hi == 0) al_l[r32] = (a); asm volatile("s_waitcnt lgkmcnt(0)" ::: "memory");              \
                     for (int d_ = 0; d_ < 4; ++d_) for (int r = 0; r < 16; ++r) o[d_][r] *= al_l[crow(r, hi)]; } } while (0)
#define KBASE(t) ((j0 + (t)) * KVBLK)
#define MASKT(P0_, P1_, t) do { const int kb_ = KBASE(t); if ((MODE != 2 || cur.kind == 0) && kb_ + KVBLK - 1 > qlo) mask_tile(P0_, P1_, qm - kb_); \
        if (MODE == 0) { const bool keep_ = (selr >> (kb_ >> 8)) & 1u; if (!__all(keep_)) { const float NEG_ = -__builtin_inff(); \
            _Pragma("unroll") for (int r = 0; r < 16; ++r) { P0_[r] = keep_ ? P0_[r] : NEG_; P1_[r] = keep_ ? P1_[r] : NEG_; } } } } while (0)
    constexpr int NQL = 8 + (MODE == 0 ? 1 : 0);
#define SEAM_K0() do { VMWN(NQL); SWRITE_HK(0); SBAR(); } while (0)
    f32x16 pA0, pA1, pB0, pB1; float mnA, mnB, alA, alB; bf16x8 pa0, pa1, pa2, pa3;
    SWRITE_HV(0); SBAR();
    if (NT > 1) SLOAD_H(cur, KBASE(1));
    SBAR(); qkt<0, MODE>(pA0, pA1, K_lds, B_lds, r32, hi, S.qr);
    MASKT(pA0, pA1, 0); partialSM<MODE != 2>(pA0, pA1, m_reg, mnA, alA);
    if (NT > 1) { VMW(); SWRITE_H(1); }
    __syncthreads();
#define HALF_STEP(PX0, PX1, mnX, alX, PY0, PY1, alY, t, KB, VB, SB) do {                                                      \
        SBAR(); qkt<KB, MODE>(PX0, PX1, K_lds, B_lds, r32, hi, S.qr);                                             \
        finishSM(PY0, PY1, alY, l_reg, pa0, pa1, pa2, pa3); SBAR();                                                           \
        if ((t) + 1 < NT) { SLOAD_H(cur, KBASE((t) + 1)); SBAR(); }                                               \
        pv_tile<VB>(o, vb0, pa0, pa1, pa2, pa3); MASKT(PX0, PX1, (t)); partialSM<MODE != 2>(PX0, PX1, m_reg, mnX, alX);                                        \
        __syncthreads();                                                                                                      \
        if ((t) + 1 < NT) { VMW(); SWRITE_H(SB); }                                                                          \
        RESC(alX); __syncthreads(); } while (0)
    for (int t = 1; t + 1 < NT; t += 2) {
        HALF_STEP(pB0, pB1, mnB, alB, pA0, pA1, alA, t, 1, 0, 0);
        HALF_STEP(pA0, pA1, mnA, alA, pB0, pB1, alB, t + 1, 0, 1, 1);
    }
    SBAR(); qkt<1, MODE>(pB0, pB1, K_lds, B_lds, r32, hi, S.qr); SBAR();
    SLOAD_H(nxt, nxt.j0 * KVBLK); SBAR();
    if (MODE == 2) { const bf16* qrow = Ptrs<MODE>::hb(BS, nxt) + (size_t)((entn & 0xffffu) * (unsigned)LDI);
#pragma unroll
        for (int d0 = 0; d0 < 8; ++d0) S.qr[d0] = load8(qrow + (unsigned)(d0 * 16 + hi * 8));
        S.selr = entn; }
    else {
#pragma unroll
    for (int d0 = 0; d0 < 8; ++d0) S.qr[d0] = load8(Ptrs<MODE>::Q(BS, nxt) + (size_t)((unsigned)(wid * QBLK + r32) * (unsigned)LDI + (unsigned)(d0 * 16 + hi * 8)));
    if (MODE == 0) S.selr = Ptrs<MODE>::Sel(BS, nxt)[(unsigned)(wid * QBLK + r32)]; }
    SBAR();
    finishSM(pA0, pA1, alA, l_reg, pa0, pa1, pa2, pa3); SBAR();
    pv_tile<0>(o, vb0, pa0, pa1, pa2, pa3);
    MASKT(pB0, pB1, NT - 1); partialSM<MODE != 2>(pB0, pB1, m_reg, mnB, alB); __syncthreads(); RESC(alB);
    finishSM(pB0, pB1, alB, l_reg, pa0, pa1, pa2, pa3); SBAR(); pv_tile<1>(o, vb0, pa0, pa1, pa2, pa3);
    SBAR(); SEAM_K0();
    if (hi == 0) li_l[r32] = l_reg; asm volatile("s_waitcnt lgkmcnt(0)" ::: "memory");
    float rli[16];
#pragma unroll
    for (int r = 0; r < 16; ++r) rli[r] = __builtin_amdgcn_rcpf(li_l[crow(r, hi)]);
    if (MODE == 2) {
        if (hi == 0 && (selr >> 31)) { float* mlp = BS.ml + (((size_t)((unsigned)cur.bh * 8192u + (selr & 0xffffu))) * 4 + ((selr >> 16) & 3u)) * 2; mlp[0] = m_reg; mlp[1] = l_reg; }
#pragma unroll
        for (int r = 0; r < 16; ++r) { const unsigned re = rowtab[crow(r, hi)]; bf16* prow = BS.part + (((size_t)((unsigned)cur.bh * 8192u + (re & 0xffffu))) * 4 + ((re >> 16) & 3u)) * 128 + (unsigned)r32; const bool st = (r32 & 1) == 0 && (re >> 31);
#pragma unroll
            for (int d0 = 0; d0 < 4; ++d0) { const float v = o[d0][r] * rli[r]; const float vn = __shfl_xor(v, 1); if (st) *(unsigned*)(prow + d0 * 32) = cvtpk(v, vn); } }
        __syncthreads(); return; }
    bf16* Ow = Ptrs<MODE>::O(BS, cur) + (size_t)((unsigned)(wid * QBLK) * (unsigned)LDO); const bf16* Gw = Ptrs<MODE>::Gt(BS, cur) + (size_t)((unsigned)(wid * QBLK) * (unsigned)LDI);
#pragma unroll
    for (int d0 = 0; d0 < 4; ++d0) {
        unsigned gp[16];
        if ((r32 & 1) == 0) {
#pragma unroll
            for (int r = 0; r < 16; ++r) gp[r] = *(const unsigned*)(Gw + (size_t)((unsigned)crow(r, hi) * (unsigned)LDI + (unsigned)(d0 * 32 + r32))); }
#pragma unroll
        for (int r = 0; r < 16; ++r) { const float v = o[d0][r] * rli[r]; const float vn = __shfl_xor(v, 1);
            if ((r32 & 1) == 0) { const float g0 = pg8::bf_lo(gp[r]), g1 = pg8::bf_hi(gp[r]);
                *(unsigned*)(Ow + (size_t)((unsigned)crow(r, hi) * (unsigned)LDO + (unsigned)(d0 * 32 + r32))) = cvtpk(v * g0 * pg8::sigmoidf_fast(g0), vn * g1 * pg8::sigmoidf_fast(g1)); } }
    }
    __syncthreads();
#undef RESC
#undef KBASE
#undef MASKT
#undef SEAM_K0
#undef HALF_STEP
}
#undef ROW
#undef VMW
#undef VMWN
#undef SLOAD_H
#undef SWRITE_HK
#undef SWRITE_HV
#undef SWRITE_H
#undef KSWZ
}

constexpr int BATCH = 2, SEQ = 8192, DM = 4096, M = BATCH * SEQ, NIN = 30728, BW = 1024, NH = 8, HD = 128, NBLK = SEQ / 256, DEPTH = 2;
constexpr int N1 = 14336;
constexpr int A_Q = 0, A_K = 1024, A_V = 2048, A_G = 3072, B_Q = 4096, B_K = 5120, B_V = 6144, B_G = 7168, C_IN = 8192, C_G = 9216, D_B = 10240, D_C = 11264, D_X = 12288, D_G = 13312;
constexpr int SRC_FORGET = 8192, SRC_SEG2 = 8200, SRC_MERGE = 14344;
constexpr float RMS_EPS = 1e-6f;
constexpr int NWAVES = 8, NTHR = 512;

constexpr size_t MiB = 1ull << 20;
constexpr size_t WS_CTL = 0, CTL_ZERO_BYTES = 1 * MiB;
constexpr size_t W1T_L = (size_t)N1 * DM * 2, WG_L = (size_t)4 * DM * DM * 2, WB_L = (size_t)4 * DM * BW * 2, WO_L = (size_t)DM * DM * 2, WP_L = (size_t)4 * 256 * 256 * 2;
constexpr size_t WS_W1T = 1 * MiB;
constexpr size_t WS_WG = WS_W1T + 2 * W1T_L;
constexpr size_t WS_WB = WS_WG + 2 * WG_L;
constexpr size_t WS_WO = WS_WB + 2 * WB_L;
constexpr size_t WS_WP = WS_WO + 2 * WO_L;
constexpr size_t WS_HN = WS_WP + 2 * WP_L;
constexpr size_t WS_PROJ = WS_HN + (size_t)M * DM * 2;
constexpr size_t WS_BR = WS_PROJ + (size_t)M * N1 * 2;
constexpr size_t WS_U = WS_BR + (size_t)4 * M * BW * 2;
constexpr size_t WS_MG = WS_U + (size_t)4 * M * DM * 2;
constexpr size_t WS_POOLED = WS_MG + (size_t)M * DM * 2;
constexpr size_t WS_LF = WS_POOLED + (size_t)M * BW * 2;
constexpr size_t WS_C32 = WS_LF + MiB;
constexpr size_t WS_BIAS = WS_C32 + MiB;
constexpr size_t WS_KMEAN = WS_BIAS + 2 * MiB;
constexpr size_t WS_SEL = WS_KMEAN + MiB;
constexpr size_t WS_WF = WS_SEL + MiB;
constexpr size_t WS_HN8 = WS_WF + MiB;
constexpr size_t WS_ORDER = WS_HN8 + (size_t)M * DM;
constexpr size_t WS_LIST = WS_ORDER + MiB;
constexpr size_t WS_PART = WS_LIST + (size_t)16 * 32 * 8192 * 4;
constexpr size_t WS_ML = WS_PART + (size_t)16 * SEQ * 4 * 128 * 2;
constexpr size_t WS_BR8 = WS_ML + (size_t)16 * SEQ * 4 * 2 * 4;
constexpr size_t WS_H1 = WS_BR8 + (size_t)M * BW;
constexpr size_t WS_H2 = WS_H1 + (size_t)M * DM * 2;
constexpr size_t WS_END = WS_H2 + (size_t)M * DM * 2;
constexpr int CW_BAR = 4096, CW_NORM = 1024  , CW_KSUM = 65536  , CW_CNT = 8192  , CW_Q = 2048  ;

constexpr int RING_BYTES = 131072, LDSCTL_OFF = 139264, MISC_OFF = LDSCTL_OFF + 320, LDS_BYTES = 147456;

__device__ __forceinline__ float wave_sum(float v) {
#pragma unroll
    for (int o = 1; o < 64; o <<= 1) v += __shfl_xor(v, o);
    return v;
}
__device__ __forceinline__ float bf2f(unsigned short b) { return __uint_as_float(((unsigned)b) << 16); }
__device__ __forceinline__ float siluf(float x) { return x * pg8::sigmoidf_fast(x); }

constexpr int TR_LD = 65, TR_BYTES = 64 * TR_LD * 4;
__device__ __forceinline__ void tr_item(const float* src, size_t ldw, bf16* dst, size_t ldt, LAS float* scr, int lane, const float* gk = nullptr  ) {
    const int l15 = lane & 15, l4 = lane >> 4;
    f32x4 v[16];
#pragma unroll
    for (int i = 0; i < 16; ++i) v[i] = __builtin_nontemporal_load((const f32x4*)(src + (size_t)(4 * i + l4) * ldw + 4 * l15));
#pragma unroll
    for (int i = 0; i < 16; ++i) { LAS float* p = scr + (4 * i + l4) * TR_LD + 4 * l15; p[0] = v[i].x; p[1] = v[i].y; p[2] = v[i].z; p[3] = v[i].w; }
    LDS_WAIT(); asm volatile("" ::: "memory");
    const int c = lane & 7;
    float g8[8];
    { f32x4 ga = {1.f, 1.f, 1.f, 1.f}, gb = ga; if (gk) { ga = *(const f32x4*)(gk + 8 * c); gb = *(const f32x4*)(gk + 8 * c + 4); }
      g8[0] = ga.x; g8[1] = ga.y; g8[2] = ga.z; g8[3] = ga.w; g8[4] = gb.x; g8[5] = gb.y; g8[6] = gb.z; g8[7] = gb.w; }
#pragma unroll
    for (int j = 0; j < 8; ++j) { const int n = (lane >> 3) + 8 * j; const LAS float* s = scr + (8 * c) * TR_LD + n;
        v4u o; o.x = pk2(s[0 * TR_LD] * g8[0], s[1 * TR_LD] * g8[1]); o.y = pk2(s[2 * TR_LD] * g8[2], s[3 * TR_LD] * g8[3]); o.z = pk2(s[4 * TR_LD] * g8[4], s[5 * TR_LD] * g8[5]); o.w = pk2(s[6 * TR_LD] * g8[6], s[7 * TR_LD] * g8[7]);
        __builtin_nontemporal_store(o, (v4u*)(dst + (size_t)n * ldt + 8 * c)); }
    LDS_WAIT(); asm volatile("" ::: "memory");
}
__device__ __forceinline__ void tr_item8(const float* src, size_t ldw, unsigned char* dst, size_t ldt, LAS float* scr, int lane, float scale, const float* gk) {
    const int l15 = lane & 15, l4 = lane >> 4;
    f32x4 v[16];
#pragma unroll
    for (int i = 0; i < 16; ++i) v[i] = __builtin_nontemporal_load((const f32x4*)(src + (size_t)(4 * i + l4) * ldw + 4 * l15));
#pragma unroll
    for (int i = 0; i < 16; ++i) { LAS float* p = scr + (4 * i + l4) * TR_LD + 4 * l15; p[0] = v[i].x; p[1] = v[i].y; p[2] = v[i].z; p[3] = v[i].w; }
    LDS_WAIT(); asm volatile("" ::: "memory");
    const int c = lane & 7;
    float g8[8];
    { f32x4 ga = {1.f, 1.f, 1.f, 1.f}, gb = ga; if (gk) { ga = *(const f32x4*)(gk + 8 * c); gb = *(const f32x4*)(gk + 8 * c + 4); }
      g8[0] = ga.x * scale; g8[1] = ga.y * scale; g8[2] = ga.z * scale; g8[3] = ga.w * scale; g8[4] = gb.x * scale; g8[5] = gb.y * scale; g8[6] = gb.z * scale; g8[7] = gb.w * scale; }
#pragma unroll
    for (int j = 0; j < 8; ++j) { const int n = (lane >> 3) + 8 * j; const LAS float* s = scr + (8 * c) * TR_LD + n;
        unsigned w0 = 0u, w1 = 0u;
        w0 = __builtin_amdgcn_cvt_pk_fp8_f32(s[0 * TR_LD] * g8[0], s[1 * TR_LD] * g8[1], w0, false); w0 = __builtin_amdgcn_cvt_pk_fp8_f32(s[2 * TR_LD] * g8[2], s[3 * TR_LD] * g8[3], w0, true);
        w1 = __builtin_amdgcn_cvt_pk_fp8_f32(s[4 * TR_LD] * g8[4], s[5 * TR_LD] * g8[5], w1, false); w1 = __builtin_amdgcn_cvt_pk_fp8_f32(s[6 * TR_LD] * g8[6], s[7 * TR_LD] * g8[7], w1, true);
        *(unsigned long long*)(dst + (size_t)n * ldt + 8 * c) = (unsigned long long)w0 | ((unsigned long long)w1 << 32); }
    LDS_WAIT(); asm volatile("" ::: "memory");
}
constexpr float WG_SCALE = 1024.0f, HN_SCALE = 16.0f, BR8_SCALE = 16.0f, WB8_SCALE = 1024.0f;
constexpr size_t W1T8_OFF = (size_t)pg8::NBFT * 256 * DM * 2;
constexpr int IT_W1A = 64 * pg8::NF8T * 4, IT_W1B = 64 * pg8::NBFT * 4, IT_WG = 64 * 256, IT_WB = 4 * 16 * 64, IT_WO = 64 * 64, IT_WP = 4 * 4 * 4;
constexpr int IT_LAYER = IT_W1A + IT_W1B + IT_WG + IT_WB + IT_WO + IT_WP;
static_assert(8 * TR_BYTES <= LDSCTL_OFF && MISC_OFF + 128 <= LDS_BYTES, "LDS map");

struct Args { const float* in[11]; float* out; unsigned char* ws; int ph_lo, ph_hi; };

struct OpsPlain { const char* A; const char* Bt; int K, lda, ldb;
    __device__ __forceinline__ const char* a_ptr(const pg8::Unit& u) const { return A + (size_t)u.pm * 256 * lda * 2; }
    __device__ __forceinline__ const char* b_ptr(const pg8::Unit& u) const { return Bt + (size_t)u.pn * 256 * ldb * 2; }
    __device__ __forceinline__ size_t hsb() const { return (size_t)pg8::HALF * ldb * 2; } };
struct OpsUp { const char* A; const char* Bt; int K, lda, ldb;
    __device__ __forceinline__ const char* a_ptr(const pg8::Unit& u) const { return A + (size_t)u.pm * 256 * 1024 * 2; }
    __device__ __forceinline__ const char* b_ptr(const pg8::Unit& u) const { return Bt + ((size_t)(u.pm >> 6) * 4096 + (size_t)u.pn * 256) * 1024 * 2; }
    __device__ __forceinline__ size_t hsb() const { return (size_t)pg8::HALF * ldb * 2; } };
struct OpsMerge { const char* A; const char* Bt; int K, lda, ldb;
    __device__ __forceinline__ const char* a_ptr(const pg8::Unit& u) const { return A + (size_t)u.pm * 256 * 4096; }
    __device__ __forceinline__ const char* b_ptr(const pg8::Unit& u) const { return Bt + ((size_t)u.z * 4096 + (size_t)u.pn * 256) * 4096; }
    __device__ __forceinline__ size_t hsb() const { return (size_t)pg8::HALF * ldb * 2; } };
struct OpsMerge2 { const char* A; const char* Bt; int K, lda, ldb;
    __device__ __forceinline__ const char* a_ptr(const pg8::Unit& u) const { return A + (size_t)u.pm * 256 * 4096; }
    __device__ __forceinline__ const char* b_ptr(const pg8::Unit& u) const { return Bt + ((size_t)(2 * u.z) * 4096 + (size_t)u.pn * 128) * 4096; }
    __device__ __forceinline__ size_t hsb() const { return (size_t)4096 * 4096; } };
struct OpsPool { const char* A; const char* Bt; int K, lda, ldb;
    __device__ __forceinline__ const char* a_ptr(const pg8::Unit& u) const { return A + (size_t)u.pm * 256 * 1024 * 2 + (size_t)u.pn * 256 * 2; }
    __device__ __forceinline__ const char* b_ptr(const pg8::Unit& u) const { return Bt + (size_t)u.pn * 256 * 256 * 2; }
    __device__ __forceinline__ size_t hsb() const { return (size_t)pg8::HALF * ldb * 2; } };

constexpr int NPL = 9, PH_FINAL = 1 + DEPTH * NPL, N_PHASES = PH_FINAL + 1;
#ifndef PH_MASK
#define PH_MASK 0x7ff
#endif
#define PHEN(k) (((PH_MASK) >> (k)) & 1)
#ifndef REP_MASK
#define REP_MASK 0
#endif
#define NREP(k) ((((REP_MASK) >> (k)) & 1) ? 2 : 1)
#ifndef ATTN_IN_KERNEL
#define ATTN_IN_KERNEL 1
#endif
#ifndef ONE_LAUNCH
#define ONE_LAUNCH 1
#endif

__device__ __forceinline__ void conv_item(unsigned char* ws, const float* w_in, const float* norm_g, const float* w_branch, const float* w_out, const float* w_pool, int it, LAS float* scr, int lane) {
            const int l = it / IT_LAYER; int r = it - l * IT_LAYER;
            const float* win_l = w_in + (size_t)l * DM * NIN;
            if (r < IT_W1A) { const int kb = r / (pg8::NF8T * 4), nb = r % (pg8::NF8T * 4), ct = pg8::nth_tile(nb >> 2, true), pc = ct * 256 + (nb & 3) * 64;
                tr_item8(win_l + (size_t)kb * 64 * NIN + (pc < 8192 ? pc : pc + 8), NIN, (unsigned char*)(ws + WS_W1T + l * W1T_L + W1T8_OFF) + (size_t)(nb * 64) * DM + kb * 64, DM, scr, lane, WG_SCALE, norm_g + (size_t)l * DM + kb * 64); return; } r -= IT_W1A;
            if (r < IT_W1B) { const int kb = r / (pg8::NBFT * 4), nb = r % (pg8::NBFT * 4), ct = pg8::nth_tile(nb >> 2, false), pc = ct * 256 + (nb & 3) * 64;
                tr_item(win_l + (size_t)kb * 64 * NIN + (pc < 8192 ? pc : pc + 8), NIN, (bf16*)(ws + WS_W1T + l * W1T_L) + (size_t)(nb * 64) * DM + kb * 64, DM, scr, lane, norm_g + (size_t)l * DM + kb * 64); return; } r -= IT_W1B;
            if (r < IT_WG) { const int kb = r / 256, nb = r % 256; tr_item8(win_l + (size_t)kb * 64 * NIN + SRC_MERGE + nb * 64, NIN, (unsigned char*)(ws + WS_WG + l * WG_L) + (size_t)(nb * 64) * DM + kb * 64, DM, scr, lane, WG_SCALE, norm_g + (size_t)l * DM + kb * 64); return; } r -= IT_WG;
            if (r < IT_WB) { const int i = r / 1024, r2 = r % 1024, kb = r2 / 64, nb = r2 % 64;
                if (i == 0) tr_item8(w_branch + ((size_t)(l * 4) * BW + kb * 64) * DM + nb * 64, DM, (unsigned char*)(ws + WS_WB + l * WB_L) + (size_t)(nb * 64) * BW + kb * 64, BW, scr, lane, WB8_SCALE, nullptr);
                else tr_item(w_branch + ((size_t)(l * 4 + i) * BW + kb * 64) * DM + nb * 64, DM, (bf16*)(ws + WS_WB + l * WB_L) + ((size_t)i * DM + nb * 64) * BW + kb * 64, BW, scr, lane);
                return; } r -= IT_WB;
            if (r < IT_WO) { const int kb = r / 64, nb = r % 64; tr_item(w_out + ((size_t)l * DM + kb * 64) * DM + nb * 64, DM, (bf16*)(ws + WS_WO + l * WO_L) + (size_t)(nb * 64) * DM + kb * 64, DM, scr, lane); return; } r -= IT_WO;
            { const int g = r / 16, r2 = r % 16, kb = r2 / 4, nb = r2 % 4;
              tr_item(w_pool + ((size_t)(l * 4 + g) * 256 + kb * 64) * 256 + nb * 64, 256, (bf16*)(ws + WS_WP + l * WP_L) + ((size_t)g * 256 + nb * 64) * 256 + kb * 64, 256, scr, lane); }
}

__global__ void __launch_bounds__(NTHR, 2) fwd(Args args) {
    extern __shared__ __attribute__((aligned(16))) unsigned char lds_raw[];
    LAS unsigned char* lds = (LAS unsigned char*)lds_raw;
    volatile LAS unsigned* MISC = (volatile LAS unsigned*)(lds + MISC_OFF);
    const int tid = threadIdx.x, lane = tid & 63, wave = __builtin_amdgcn_readfirstlane(tid >> 6);
    const int G = gridDim.x, bx = blockIdx.x;
#define KA_LOAD const Args* ka_ = &args; unsigned char* const ws = ka_->ws; gu32* const ctl = (gu32*)(ws + WS_CTL); \
    const float* const x = ka_->in[0]; const float* const norm_g = ka_->in[1]; const float* const w_in = ka_->in[2]; const float* const b_forget = ka_->in[3]; const float* const w_pool = ka_->in[4]; \
    const float* const pool_scale = ka_->in[5]; const float* const w_conv = ka_->in[6]; const float* const w_branch = ka_->in[7]; const float* const b_merge = ka_->in[8]; const float* const w_out = ka_->in[9]; \
    const float* const final_g = ka_->in[10]; float* const out = ka_->out; \
    bf16* const HN = (bf16*)(ws + WS_HN); bf16* const PROJ = (bf16*)(ws + WS_PROJ); bf16* const BR = (bf16*)(ws + WS_BR); bf16* const U = (bf16*)(ws + WS_U); bf16* const MG = (bf16*)(ws + WS_MG); bf16* const POOLED = (bf16*)(ws + WS_POOLED); \
    float* const LF = (float*)(ws + WS_LF); float* const C32 = (float*)(ws + WS_C32); v4u* const BIAS = (v4u*)(ws + WS_BIAS); float* const KMEAN = (float*)(ws + WS_KMEAN); unsigned* const SEL = (unsigned*)(ws + WS_SEL); \
    (void)ctl; (void)x; (void)norm_g; (void)w_in; (void)b_forget; (void)w_pool; (void)pool_scale; (void)w_conv; (void)w_branch; (void)b_merge; (void)w_out; (void)final_g; (void)out; \
    (void)HN; (void)PROJ; (void)BR; (void)U; (void)MG; (void)POOLED; (void)LF; (void)C32; (void)BIAS; (void)KMEAN; (void)SEL;
#define KA_LAYER const float* const win_l = w_in + (size_t)l * DM * NIN; (void)win_l;
    gu32* const ctl0 = (gu32*)(args.ws + WS_CTL);
    for (int u = tid; u < (LDS_BYTES - LDSCTL_OFF) / 4; u += NTHR) ((LAS unsigned*)(lds + LDSCTL_OFF))[u] = 0u;
    __syncthreads();
    const int lo = args.ph_lo, hi = args.ph_hi;
    const bool multi = (hi - lo) > 1;
    XcdBarrier bar; bar.bar = (unsigned*)(ctl0 + CW_BAR); bar.x = 0; bar.st = nullptr;
    if (multi) bar = xcd_barrier_post((unsigned*)(ctl0 + CW_BAR), MISC + 8);
#define IN(k) (lo <= (k) && (k) < hi)
#ifndef BAR_REP
#define BAR_REP 1
#endif
#ifndef PROBE_PH
#define PROBE_PH (-1)
#endif
    unsigned long long pt0_ = (PROBE_PH == 0) ? rt() : 0ull, pacc_ = 0ull;
#ifndef PROBE_AVG
#define PROBE_AVG (-1)
#endif
#define SEAM(k) do { if (PROBE_AVG == (k) && threadIdx.x == 0) __hip_atomic_fetch_add(ctl0 + 210, (unsigned)(rt() - pt0_), RLX_AGENT); \
        if (IN(k) && IN((k) + 1)) { for (int br_ = 0; br_ < BAR_REP; ++br_) xcd_barrier(bar); } if (PROBE_PH == (k)) pacc_ = rt() - pt0_; if (PROBE_PH == (k) + 1 || PROBE_AVG == (k) + 1) pt0_ = rt(); } while (0)
    const int NGW = G * NWAVES;
#define PHASE_IDS int tid_o = threadIdx.x; asm volatile("" : "+v"(tid_o)); const int tid = tid_o, lane = tid & 63, wave = __builtin_amdgcn_readfirstlane(tid >> 6), gw = bx * NWAVES + wave; (void)lane; (void)gw;
#define CONV_FILL(k_, DRAIN_) do { if (l == 0 && DEPTH > 1 && (lo <= (k_) && (k_) < hi)) { PHASE_IDS KA_LOAD LAS int* tk_ = (LAS int*)(lds + 133184); LAS float* scr_ = (LAS float*)(lds + wave * TR_BYTES); \
        __syncthreads(); if (threadIdx.x == 0 && !(DRAIN_)) __hip_atomic_fetch_add(ctl + 300 + (k_), 1u, RLX_AGENT); \
        for (;;) { __syncthreads(); if (threadIdx.x == 0) { int v_ = IT_LAYER; if ((DRAIN_) || __hip_atomic_load(ctl + 300 + (k_), RLX_AGENT) < (unsigned)G) v_ = (int)__hip_atomic_fetch_add(ctl + 298, 8u, RLX_AGENT); tk_[0] = v_; } __syncthreads(); \
            const int b_ = __builtin_amdgcn_readfirstlane(tk_[0]); if (b_ >= IT_LAYER) break; \
            if (b_ + wave < IT_LAYER) conv_item(ws, w_in, norm_g, w_branch, w_out, w_pool, IT_LAYER + b_ + wave, scr_, lane); } } } while (0)

    for (int rep_ = 0; rep_ < NREP(0); ++rep_) if (PHEN(0) && IN(0)) { PHASE_IDS KA_LOAD
        LAS float* scr = (LAS float*)(lds + wave * TR_BYTES);
        for (int it = gw; it < IT_LAYER; it += NGW) conv_item(ws, w_in, norm_g, w_branch, w_out, w_pool, it, scr, lane);
        for (int i = bx * NTHR + tid; i < DEPTH * DM; i += G * NTHR) { const int l = i / DM, k = i - l * DM; const float* p = w_in + ((size_t)l * DM + k) * NIN + SRC_FORGET;
            const float gk_ = norm_g[i]; const f32x4 a = *(const f32x4*)p * gk_, b = *(const f32x4*)(p + 4) * gk_; float* o = (float*)(ws + WS_WF) + (size_t)l * 8 * DM + k;
            o[0 * DM] = a.x; o[1 * DM] = a.y; o[2 * DM] = a.z; o[3 * DM] = a.w; o[4 * DM] = b.x; o[5 * DM] = b.y; o[6 * DM] = b.z; o[7 * DM] = b.w; }
    }
    SEAM(0);

    for (int l = 0; l < DEPTH; ++l) {
        const int pb = 1 + l * NPL;

        for (int rep_ = 0; rep_ < NREP(1); ++rep_) if (PHEN(1) && IN(pb + 0)) { PHASE_IDS KA_LOAD KA_LAYER
            LAS float* wfT = (LAS float*)lds;
            { const f32x4* wsrc = (const f32x4*)((const float*)(ws + WS_WF) + (size_t)l * 8 * DM);
              for (int i = tid; i < 8 * DM / 4; i += NTHR) ((LAS f32x4*)wfT)[i] = wsrc[i]; }
            __syncthreads();
#define NORM_CHUNK(A0_, A1_, C_) do { if (BF_) { const v4u w_ = rawb[C_]; A0_ = (f32x4){pg8::bf_lo(w_.x), pg8::bf_hi(w_.x), pg8::bf_lo(w_.y), pg8::bf_hi(w_.y)}; A1_ = (f32x4){pg8::bf_lo(w_.z), pg8::bf_hi(w_.z), pg8::bf_lo(w_.w), pg8::bf_hi(w_.w)}; } \
                else { A0_ = rawf[2 * (C_)]; A1_ = rawf[2 * (C_) + 1]; } } while (0)
#define NORM_FETCH(ROW_, C_) do { if (BF_) rawb[C_] = *(const v4u*)((const bf16*)(ws + WS_H1) + (size_t)(ROW_) * DM + 8 * (lane + 64 * (C_))); \
                else { const float* p_ = x + (size_t)(ROW_) * DM + 8 * (lane + 64 * (C_)); rawf[2 * (C_)] = *(const f32x4*)p_; rawf[2 * (C_) + 1] = *(const f32x4*)(p_ + 4); } } while (0)
#define NORM_ROW(PF_) do { float ss = 0.f; \
                _Pragma("unroll") for (int c = 0; c < 8; ++c) { f32x4 a0, a1; NORM_CHUNK(a0, a1, c); ss += ((a0.x * a0.x + a0.y * a0.y) + (a0.z * a0.z + a0.w * a0.w)) + ((a1.x * a1.x + a1.y * a1.y) + (a1.z * a1.z + a1.w * a1.w)); } \
                const float rstd = 1.0f / sqrtf(wave_sum(ss) * (1.0f / DM) + RMS_EPS); \
                float fa[8] = {0.f, 0.f, 0.f, 0.f, 0.f, 0.f, 0.f, 0.f}; \
                _Pragma("unroll") for (int c = 0; c < 8; ++c) { f32x4 y0, y1; NORM_CHUNK(y0, y1, c); y0 = y0 * rstd; y1 = y1 * rstd; const int e0 = 8 * (lane + 64 * c); \
                    if (PF_) NORM_FETCH(row + NGW, c); \
                    *(v4u*)(HN + (size_t)row * DM + e0) = (v4u){pk2(y0.x, y0.y), pk2(y0.z, y0.w), pk2(y1.x, y1.y), pk2(y1.z, y1.w)}; \
                    { unsigned w8 = 0u, w9 = 0u; w8 = __builtin_amdgcn_cvt_pk_fp8_f32(__builtin_amdgcn_fmed3f(y0.x * HN_SCALE, -440.f, 440.f), __builtin_amdgcn_fmed3f(y0.y * HN_SCALE, -440.f, 440.f), w8, false); w8 = __builtin_amdgcn_cvt_pk_fp8_f32(__builtin_amdgcn_fmed3f(y0.z * HN_SCALE, -440.f, 440.f), __builtin_amdgcn_fmed3f(y0.w * HN_SCALE, -440.f, 440.f), w8, true); \
                      w9 = __builtin_amdgcn_cvt_pk_fp8_f32(__builtin_amdgcn_fmed3f(y1.x * HN_SCALE, -440.f, 440.f), __builtin_amdgcn_fmed3f(y1.y * HN_SCALE, -440.f, 440.f), w9, false); w9 = __builtin_amdgcn_cvt_pk_fp8_f32(__builtin_amdgcn_fmed3f(y1.z * HN_SCALE, -440.f, 440.f), __builtin_amdgcn_fmed3f(y1.w * HN_SCALE, -440.f, 440.f), w9, true); \
                      *(unsigned long long*)(ws + WS_HN8 + (size_t)row * DM + e0) = (unsigned long long)w8 | ((unsigned long long)w9 << 32); } \
                    _Pragma("unroll") for (int h = 0; h < 8; ++h) { const f32x4 w0 = *(const LAS f32x4*)(wfT + h * DM + e0), w1 = *(const LAS f32x4*)(wfT + h * DM + e0 + 4); \
                        fa[h] += ((y0.x * w0.x + y0.y * w0.y) + (y0.z * w0.z + y0.w * w0.w)) + ((y1.x * w1.x + y1.y * w1.y) + (y1.z * w1.z + y1.w * w1.w)); } \
                    asm volatile("" ::: "memory"); } \
                _Pragma("unroll") for (int h = 0; h < 8; ++h) fa[h] = wave_sum(fa[h]); \
                float mine = fa[0]; \
                _Pragma("unroll") for (int h = 1; h < 8; ++h) mine = (lane == h) ? fa[h] : mine; \
                if (lane < 8) { const float z = mine + b_forget[l * NH + lane]; const float ls = fminf(z, 0.f) - 0.6931471805599453f * __builtin_amdgcn_logf(1.0f + __builtin_amdgcn_exp2f(-1.4426950408889634f * fabsf(z))); \
                    LF[((size_t)(row / SEQ) * NH + lane) * SEQ + (row % SEQ)] = ls; } } while (0)
            if (gw < M) {
                if (l == 0) { constexpr bool BF_ = false; f32x4 rawf[16]; v4u rawb[1]; (void)rawb;
#pragma unroll
                    for (int c = 0; c < 8; ++c) NORM_FETCH(gw, c);
                    int row = gw; for (; row + NGW < M; row += NGW) NORM_ROW(true); NORM_ROW(false); }
                else { constexpr bool BF_ = true; v4u rawb[8]; f32x4 rawf[1]; (void)rawf;
#pragma unroll
                    for (int c = 0; c < 8; ++c) NORM_FETCH(gw, c);
                    int row = gw; for (; row + NGW < M; row += NGW) NORM_ROW(true); NORM_ROW(false); } }
#undef NORM_ROW
#undef NORM_FETCH
#undef NORM_CHUNK
        }
        SEAM(pb + 0);

        for (int rep_ = 0; rep_ < NREP(2); ++rep_) if (PHEN(2) && IN(pb + 1)) { KA_LOAD KA_LAYER
            { OpsPlain O{(const char*)(ws + WS_HN8), (const char*)(ws + WS_W1T + l * W1T_L + W1T8_OFF), DM / 2, DM / 2, DM / 2};
              pg8::StaticOrder S; S.init(M, pg8::NF8T * 256, G, bx);
              pg8::EpiProj<0> E{PROJ, N1, (float*)((unsigned*)ctl + CW_KSUM + l * 65536), (unsigned*)ctl + CW_NORM + l * 128, 1.0f / (WG_SCALE * HN_SCALE)};
              pg8::gemm_phase<pg8::EpiProj<0>, pg8::StaticOrder, OpsPlain, true, true, 1>(lds, O, S, E); }
            { OpsPlain O{(const char*)HN, (const char*)(ws + WS_W1T + l * W1T_L), DM, DM, DM};
              pg8::StaticOrder S; S.init(M, pg8::NBFT * 256, G, bx);
              pg8::EpiProj<1> E{PROJ, N1, (float*)((unsigned*)ctl + CW_KSUM + l * 65536), (unsigned*)ctl + CW_NORM + l * 128, 1.0f};
              pg8::gemm_phase<pg8::EpiProj<1>, pg8::StaticOrder, OpsPlain, true, true, 0>(lds, O, S, E); }
        }
        SEAM(pb + 1);

        for (int rep_ = 0; rep_ < NREP(3); ++rep_) if (PHEN(3) && IN(pb + 2)) { PHASE_IDS KA_LOAD KA_LAYER
            { LAS double* sd = (LAS double*)lds;
              for (int ub = G - 1 - bx; ub < BATCH * NH; ub += G) { const size_t e0 = (size_t)ub * SEQ + 1024 * wave + lane; float xf[16]; double cv[16]; double carry = 0.0;
#pragma unroll
                for (int r = 0; r < 16; ++r) xf[r] = LF[e0 + 64 * r];
#pragma unroll
                for (int r = 0; r < 16; ++r) { double x = (double)xf[r];
#pragma unroll
                    for (int o = 1; o < 64; o <<= 1) { const double y = __shfl_up(x, o); if (lane >= o) x += y; }
                    cv[r] = carry + x; carry += __shfl(x, 63); }
                if (lane == 0) sd[wave] = carry; __syncthreads();
                double excl = 0.0;
#pragma unroll
                for (int w = 0; w < 8; ++w) { const double tw = sd[w]; excl += (w < wave) ? tw : 0.0; }
#pragma unroll
                for (int r = 0; r < 16; ++r) { const double c = excl + cv[r]; C32[e0 + 64 * r] = (float)c;
                    const double xx = -c * 11.313708498984761; const unsigned b1 = f2bf((float)xx); const double r1 = xx - (double)__uint_as_float(b1 << 16);
                    const unsigned b2 = f2bf((float)r1); const double r2 = r1 - (double)__uint_as_float(b2 << 16); const unsigned b3 = f2bf((float)r2);
                    BIAS[e0 + 64 * r] = (v4u){b1 | (b2 << 16), b3, 0u, 0u}; }
                __syncthreads(); } }
            { const float* wc_l = w_conv + (size_t)l * 3 * BW;
              for (int idx = bx * NTHR + tid; idx < (M / 16) * 128; idx += G * NTHR) { const int row0 = (idx >> 7) * 16, col = (idx & 127) * 8, t0 = row0 & (SEQ - 1);
#define LD8(f_, p_) do { const v4u w_ = *(const v4u*)(p_); f_[0] = pg8::bf_lo(w_.x); f_[1] = pg8::bf_hi(w_.x); f_[2] = pg8::bf_lo(w_.y); f_[3] = pg8::bf_hi(w_.y); f_[4] = pg8::bf_lo(w_.z); f_[5] = pg8::bf_hi(w_.z); f_[6] = pg8::bf_lo(w_.w); f_[7] = pg8::bf_hi(w_.w); } while (0)
                { const int win = 2 << (col >> 8); const bf16* p = PROJ + (size_t)row0 * N1 + C_IN + col; float sacc[8] = {0.f, 0.f, 0.f, 0.f, 0.f, 0.f, 0.f, 0.f};
                  for (int j = win - 1; j >= 1; --j) if (t0 - j >= 0) { float f[8]; LD8(f, p - (ptrdiff_t)j * (ptrdiff_t)N1);
#pragma unroll
                      for (int e = 0; e < 8; ++e) sacc[e] += f[e]; }
#pragma unroll 4
                  for (int i = 0; i < 16; ++i) { const int t = t0 + i; float f[8]; LD8(f, p + (size_t)i * N1);
#pragma unroll
                      for (int e = 0; e < 8; ++e) sacc[e] += f[e];
                      { const bool lv = i > 0 && t - win >= 0; float g[8]; LD8(g, p + (lv ? (ptrdiff_t)(i - win) * (ptrdiff_t)N1 : (ptrdiff_t)0));
#pragma unroll
                        for (int e = 0; e < 8; ++e) sacc[e] -= lv ? g[e] : 0.f; }
                      const float inv = 1.0f / (float)((t + 1 < win) ? t + 1 : win); float o[8];
#pragma unroll
                      for (int e = 0; e < 8; ++e) o[e] = sacc[e] * inv - f[e];
                      *(v4u*)(POOLED + (size_t)(row0 + i) * BW + col) = (v4u){pk2(o[0], o[1]), pk2(o[2], o[3]), pk2(o[4], o[5]), pk2(o[6], o[7])}; } }
                { float w0[8], w1[8], w2[8], zp[8], zpp[8]; const bf16* p = PROJ + (size_t)row0 * N1 + col;
                  { const f32x4 a0 = *(const f32x4*)(wc_l + col), a1 = *(const f32x4*)(wc_l + col + 4), b0 = *(const f32x4*)(wc_l + BW + col), b1 = *(const f32x4*)(wc_l + BW + col + 4), c0 = *(const f32x4*)(wc_l + 2 * BW + col), c1 = *(const f32x4*)(wc_l + 2 * BW + col + 4);
#pragma unroll
                    for (int e = 0; e < 4; ++e) { w0[e] = a0[e]; w0[4 + e] = a1[e]; w1[e] = b0[e]; w1[4 + e] = b1[e]; w2[e] = c0[e]; w2[4 + e] = c1[e]; } }
#pragma unroll
                  for (int e = 0; e < 8; ++e) { zp[e] = 0.f; zpp[e] = 0.f; }
                  if (t0 >= 2) { float c[8], xx[8]; LD8(c, p - 2 * (ptrdiff_t)N1 + D_C); LD8(xx, p - 2 * (ptrdiff_t)N1 + D_X);
#pragma unroll
                      for (int e = 0; e < 8; ++e) zpp[e] = c[e] * xx[e]; }
                  if (t0 >= 1) { float c[8], xx[8]; LD8(c, p - (ptrdiff_t)N1 + D_C); LD8(xx, p - (ptrdiff_t)N1 + D_X);
#pragma unroll
                      for (int e = 0; e < 8; ++e) zp[e] = c[e] * xx[e]; }
#pragma unroll 4
                  for (int i = 0; i < 16; ++i) { const bf16* pr = p + (size_t)i * N1; float c[8], xx[8], bb[8], gg[8], o[8]; LD8(c, pr + D_C); LD8(xx, pr + D_X); LD8(bb, pr + D_B); LD8(gg, pr + D_G);
#pragma unroll
                      for (int e = 0; e < 8; ++e) { const float z = c[e] * xx[e]; const float y = w0[e] * zpp[e] + w1[e] * zp[e] + w2[e] * z; zpp[e] = zp[e]; zp[e] = z; o[e] = bb[e] * y * siluf(gg[e]); }
                      *(v4u*)(BR + ((size_t)3 * M + row0 + i) * BW + col) = (v4u){pk2(o[0], o[1]), pk2(o[2], o[3]), pk2(o[4], o[5]), pk2(o[6], o[7])}; } }
#undef LD8
              } }
        }
        CONV_FILL(pb + 2, false);
        SEAM(pb + 2);

        for (int rep_ = 0; rep_ < NREP(4); ++rep_) if (PHEN(4) && IN(pb + 3)) { PHASE_IDS KA_LOAD KA_LAYER
#ifndef SUBREP
#define SUBREP 0
#endif
#ifndef STAG_US
#define STAG_US 0
#endif
#ifndef FOX_OVH
#define FOX_OVH 3
#endif
            for (int sr_ = 0; sr_ < ((SUBREP == 1) ? 2 : 1); ++sr_)
            { LAS float* km = (LAS float*)lds;
              const int nsw = G;
              const int half = tid >> 8, ti = tid & 255;
              for (int base = (bx < nsw ? bx : 256); base < 256; base += 2 * nsw) { const int un = base + half * nsw; const bool act = un < 256; const int bhs = act ? (un >> 4) : 0, y = un & 15;
                const float* ksrc = (const float*)((const unsigned*)ctl + CW_KSUM + l * 65536) + (size_t)bhs * NBLK * HD; LAS float* kmh = km + half * 4096;
                if (act) { const f32x4* k4 = (const f32x4*)ksrc; LAS f32x4* d4 = (LAS f32x4*)kmh; f32x4 tmp[4];
#pragma unroll
                    for (int i = 0; i < 4; ++i) { const int e = ti + 256 * i; tmp[i] = (e < 992) ? k4[e] : (f32x4){0.f, 0.f, 0.f, 0.f}; }
#pragma unroll
                    for (int i = 0; i < 4; ++i) { const int e = ti + 256 * i; if (e < 992) d4[e] = tmp[i] * (1.0f / 256.0f); } }
                __syncthreads();
                if (act) for (int pass = 0; pass < 2; ++pass) { const int qb = pass ? 31 - y : y, t = qb * 256 + ti;
                    const size_t row = (size_t)(bhs >> 3) * SEQ + t; const v4u* qp4 = (const v4u*)(PROJ + row * N1 + A_Q + (bhs & 7) * HD); v4u qv[16];
#pragma unroll
                    for (int i = 0; i < 16; ++i) qv[i] = qp4[i];
                    float v0 = -3.0e38f, v1 = -3.0e38f, v2 = -3.0e38f; int i0 = -1, i1 = -1, i2 = -1;
                    for (int n = 0; n < qb; ++n) { float s0 = 0.f, s1 = 0.f, s2 = 0.f, s3 = 0.f; const LAS f32x4* kr = (const LAS f32x4*)(kmh + n * HD);
#pragma unroll
                        for (int i = 0; i < 16; ++i) { const f32x4 ka = kr[2 * i], kb = kr[2 * i + 1];
                            s0 += pg8::bf_lo(qv[i].x) * ka.x; s1 += pg8::bf_hi(qv[i].x) * ka.y; s2 += pg8::bf_lo(qv[i].y) * ka.z; s3 += pg8::bf_hi(qv[i].y) * ka.w;
                            s0 += pg8::bf_lo(qv[i].z) * kb.x; s1 += pg8::bf_hi(qv[i].z) * kb.y; s2 += pg8::bf_lo(qv[i].w) * kb.z; s3 += pg8::bf_hi(qv[i].w) * kb.w; }
                        const float sc_ = (s0 + s1) + (s2 + s3);
                        if (sc_ > v0) { v2 = v1; i2 = i1; v1 = v0; i1 = i0; v0 = sc_; i0 = n; } else if (sc_ > v1) { v2 = v1; i2 = i1; v1 = sc_; i1 = n; } else if (sc_ > v2) { v2 = sc_; i2 = n; } }
                    unsigned mask = 1u << qb; if (i0 >= 0) mask |= 1u << i0; if (i1 >= 0) mask |= 1u << i1; if (i2 >= 0) mask |= 1u << i2;
                    SEL[(size_t)bhs * SEQ + t] = mask;
                    { const unsigned long long lt = (1ull << lane) - 1ull; int r0 = 0, r1 = 0, r2 = 0, mycnt = 0;
                      for (int nn = 0; nn < qb; ++nn) { const unsigned long long m0 = __ballot(i0 == nn), m1 = __ballot(i1 == nn), m2 = __ballot(i2 == nn); const int c0 = __popcll(m0), c1 = __popcll(m1);
                          if (i0 == nn) r0 = __popcll(m0 & lt); if (i1 == nn) r1 = c0 + __popcll(m1 & lt); if (i2 == nn) r2 = c0 + c1 + __popcll(m2 & lt);
                          if (lane == nn) mycnt = c0 + c1 + __popcll(m2); }
                      unsigned basev = 0u; if (lane < qb && mycnt > 0) basev = __hip_atomic_fetch_add(ctl + CW_CNT + l * 512 + bhs * 32 + lane, (unsigned)mycnt, RLX_AGENT);
                      const unsigned b0 = (unsigned)__shfl((int)basev, i0 < 0 ? 0 : i0), b1 = (unsigned)__shfl((int)basev, i1 < 0 ? 0 : i1), b2 = (unsigned)__shfl((int)basev, i2 < 0 ? 0 : i2);
                      unsigned* LISTS = (unsigned*)(ws + WS_LIST) + (size_t)bhs * 32 * 8192;
                      if (i0 >= 0) LISTS[(size_t)i0 * 8192 + b0 + r0] = (unsigned)t;
                      if (i1 >= 0) LISTS[(size_t)i1 * 8192 + b1 + r1] = (unsigned)t | (1u << 16);
                      if (i2 >= 0) LISTS[(size_t)i2 * 8192 + b2 + r2] = (unsigned)t | (2u << 16); } }
                __syncthreads(); } }
            for (int sr_ = 0; sr_ < ((SUBREP == 2) ? 2 : 1); ++sr_)
            if (bx >= G - 8) { const int vq = G - 1 - bx;
                LAS int* wsh = (LAS int*)lds; LAS int* wbh = wsh + 512; LAS int* pr2 = wbh + 16; LAS int* itw = pr2 + 16; LAS int* srt = itw + 128; LAS int* load = srt + 128; LAS int* asg = load + 32;
                const int bh = tid >> 5, qb = tid & 31;
                float qm2 = 0.f, km2 = 0.f;
#pragma unroll
                for (int g4 = 0; g4 < 4; ++g4) { qm2 += __uint_as_float(__hip_atomic_load((unsigned*)ctl + CW_NORM + l * 128 + (bh * 2) * 4 + g4, __ATOMIC_RELAXED, __HIP_MEMORY_SCOPE_AGENT)); km2 += __uint_as_float(__hip_atomic_load((unsigned*)ctl + CW_NORM + l * 128 + (bh * 2 + 1) * 4 + g4, __ATOMIC_RELAXED, __HIP_MEMORY_SCOPE_AGENT)); }
                const float TH = 2.0f * sqrtf(qm2 * km2) * 0.08838834764831845f + 40.0f; const float c0 = C32[(size_t)bh * SEQ + qb * 256];
                LAS float* cend = (LAS float*)(lds + 32768);
#pragma unroll
                for (int i = 0; i < 4; ++i) { const int e = tid * 4 + i; cend[e] = C32[(size_t)(e >> 7) * SEQ + 64 * (e & 127) + 63]; }
                __syncthreads();
                int lo_ = 0, hi_ = 4 * qb;
                while (lo_ < hi_) { const int mid = (lo_ + hi_) >> 1; if (cend[bh * 128 + mid] - c0 > TH) lo_ = mid + 1; else hi_ = mid; }
                lo_ &= ~1;
                wsh[tid] = (4 * (qb + 1) - lo_ + FOX_OVH) | (lo_ << 16); __syncthreads();
                if (tid < 16) { int sacc = 0; for (int j = 0; j < 32; ++j) sacc += wsh[tid * 32 + j] & 0xffff; wbh[tid] = sacc; } __syncthreads();
                if (tid < 16) { const int b_ = tid >> 3, h_ = tid & 7; int rk = 0; for (int j = 0; j < 8; ++j) { const int wj = wbh[b_ * 8 + j]; rk += (wj > wbh[tid] || (wj == wbh[tid] && j < h_)) ? 1 : 0; }
                    const int p_ = rk < 4 ? rk : 7 - rk; pr2[(b_ * 4 + p_) * 2 + (rk < 4 ? 0 : 1)] = tid; }
                __syncthreads();
                int myw = 0; unsigned myent = 0u;
                if (tid < 64) { const int qq = tid & 31, fb = pr2[vq * 2 + (tid >> 5)], v = wsh[fb * 32 + qq]; myw = v & 0xffff; myent = ((unsigned)(v >> 16) << 16) | (unsigned)(fb * 32 + qq); itw[tid] = myw; }
                __syncthreads();
                if (tid < 64) { int r = 0; for (int j = 0; j < 64; ++j) { const int wj = itw[j]; r += (wj > myw || (wj == myw && j < tid)) ? 1 : 0; } srt[r] = tid; }
                __syncthreads();
                if (tid < 32) { const int it = srt[tid]; load[tid] = itw[it]; asg[tid * 4] = it; } __syncthreads();
                { int r = 0, mine = 0;
                  if (tid < 32) { mine = load[tid]; for (int j = 0; j < 32; ++j) { const int lj = load[j]; r += (lj < mine || (lj == mine && j < tid)) ? 1 : 0; } }
                  __syncthreads();
                  if (tid < 32) { const int it = srt[32 + r]; load[tid] = mine + itw[it]; asg[tid * 4 + 1] = it; }
                  __syncthreads(); }
                LAS unsigned* ent = (LAS unsigned*)(asg + 128); if (tid < 64) ent[tid] = myent; __syncthreads();
                if (tid < 32) { unsigned* dst = (unsigned*)(ws + WS_ORDER) + (vq + 8 * tid) * 16;
                    dst[8] = ent[asg[tid * 4]]; dst[9] = ent[asg[tid * 4 + 1]]; const unsigned two_ = 2u + ((unsigned)tid >> 9);
                    dst[0] = two_ - 2u; dst[1] = two_; dst[2] = (unsigned)load[tid]; }
                __syncthreads(); }
        }
        SEAM(pb + 3);

        for (int rep_ = 0; rep_ < NREP(5); ++rep_) if (PHEN(5) && IN(pb + 4)) { KA_LOAD KA_LAYER
#if ATTN_IN_KERNEL
            const unsigned* LST = (const unsigned*)(ws + WS_ORDER);
#define ATT_REF(E_, R_) do { const unsigned e_ = (E_); (R_).bh = (int)((e_ >> 5) & 15u); (R_).qb = (int)(e_ & 31u); (R_).j0 = (int)(e_ >> 16); (R_).kind = 0; (R_).lbase = 0; (R_).nval = 256; } while (0)
            const att::Bases BS{PROJ, BR, BIAS, SEL, (const unsigned*)(ws + WS_LIST), (bf16*)(ws + WS_PART), (float*)(ws + WS_ML)};
#define ATT_STREAM(MODE_) do { for (int bin = bx; bin < 256; bin += G) { const unsigned* rec = LST + bin * 16; const int n_ = (int)rec[(MODE_) ? 1 : 0]; \
                if (n_ > 0) { const unsigned* ents = rec + ((MODE_) ? 8 : 4); att::BlockRef cur, nxt; ATT_REF(ents[0], cur); att::Seam S; att::attn_prime<MODE_>(BS, cur, (char*)lds_raw, S); \
                    for (int k_ = 0; k_ < n_; ++k_) { if (k_ + 1 < n_) ATT_REF(ents[k_ + 1], nxt); else nxt = cur; att::attn_block<MODE_>(BS, cur, nxt, (char*)lds_raw, S); cur = nxt; } } } } while (0)
            for (int ar_ = 0; ar_ < ((SUBREP == 5) ? 2 : 1); ++ar_)
            ATT_STREAM(1);
#if DIAG_MOBA == 1
            for (int idx = bx; idx < 512; idx += G) { att::BlockRef cur; cur.bh = idx & 15; cur.qb = idx >> 4; cur.j0 = 0; cur.kind = 0; cur.lbase = 0; cur.nval = 256; att::Seam S; att::attn_prime<0>(BS, cur, (char*)lds_raw, S); att::attn_block<0>(BS, cur, cur, (char*)lds_raw, S); }
#endif
            for (int ar_ = 0; ar_ < ((SUBREP == 6) ? 2 : 1); ++ar_)
            for (int bin = bx; bin < 256; bin += G) { const int vx = bin & 7, lb = bin >> 3;
                LAS int* PFX = (LAS int*)(lds + 98304); LAS int* CNL = PFX + 64; LAS int* UR = CNL + 64;
                __syncthreads();
                int tj_ = threadIdx.x; asm volatile("" : "+v"(tj_));
                if (tj_ < 64) { const int j = tj_; const int c = (int)__hip_atomic_load(ctl + CW_CNT + l * 512 + (2 * vx + (j >> 5)) * 32 + (j & 31), RLX_AGENT); const int ch = (c + 255) >> 8;
                    int inc = ch;
#pragma unroll
                    for (int o = 1; o < 64; o <<= 1) { const int v = __shfl_up(inc, o); if (j >= o) inc += v; }
                    PFX[j] = inc - ch; CNL[j] = c; const int U = 64 + __shfl(inc, 63);
                    const int Li = (j < 32) ? (int)LST[(vx + 8 * j) * 16 + 2] : 0x3fffffff; constexpr int WU = 8;
                    int lo_ = 0, hi_ = 8192;
                    while (lo_ < hi_) { const int mid = (lo_ + hi_) >> 1; int ni = (mid > Li) ? (mid - Li) / WU : 0;
#pragma unroll
                        for (int o = 1; o < 64; o <<= 1) ni += __shfl_xor(ni, o);
                        if (ni >= U) hi_ = mid; else lo_ = mid + 1; }
                    int ni = (lo_ > Li) ? (lo_ - Li) / WU : 0; int tot = ni;
#pragma unroll
                    for (int o = 1; o < 64; o <<= 1) tot += __shfl_xor(tot, o);
                    int excess = tot - U;
                    while (excess > 0) { const unsigned long long pm = __ballot(ni > 0); const int rk = __popcll(pm & ((1ull << j) - 1ull)); if (ni > 0 && rk < excess) --ni; const int np = __popcll(pm); excess -= (np < excess ? np : excess); }
                    int inc2 = ni;
#pragma unroll
                    for (int o = 1; o < 64; o <<= 1) { const int v = __shfl_up(inc2, o); if (j >= o) inc2 += v; }
                    if (j == lb) { UR[0] = inc2 - ni; UR[1] = ni; } }
                __syncthreads();
                const int u0 = __builtin_amdgcn_readfirstlane(UR[0]), un = __builtin_amdgcn_readfirstlane(UR[1]);
#define ATT_UNIT(U_, R_) do { const int u_ = (U_); if (u_ < 64) { (R_).bh = 2 * vx + (u_ >> 5); (R_).qb = u_ & 31; (R_).j0 = 4 * (u_ & 31); (R_).kind = 0; (R_).lbase = 0; (R_).nval = 256; } \
                    else { const int g_ = u_ - 64; int a_ = 0, b_ = 63; while (a_ < b_) { const int m_ = (a_ + b_ + 1) >> 1; if (__builtin_amdgcn_readfirstlane(PFX[m_]) <= g_) a_ = m_; else b_ = m_ - 1; } \
                        const int ck_ = g_ - __builtin_amdgcn_readfirstlane(PFX[a_]), cn_ = __builtin_amdgcn_readfirstlane(CNL[a_]) - ck_ * 256; (R_).bh = 2 * vx + (a_ >> 5); (R_).qb = 0; (R_).j0 = 4 * (a_ & 31); (R_).kind = 1; \
                        (R_).lbase = ((R_).bh * 32 + (a_ & 31)) * 8192 + ck_ * 256; (R_).nval = cn_ < 256 ? cn_ : 256; } } while (0)
                if (un > 0) { att::BlockRef cur, nxt; ATT_UNIT(u0, cur); att::Seam S; att::attn_prime<2>(BS, cur, (char*)lds_raw, S);
                    for (int k_ = 0; k_ < un; ++k_) { if (k_ + 1 < un) ATT_UNIT(u0 + k_ + 1, nxt); else nxt = cur; att::attn_block<2>(BS, cur, nxt, (char*)lds_raw, S); cur = nxt; } }
#undef ATT_UNIT
            }
            { LAS int* tk = (LAS int*)(lds + 131072 + 64);
              for (;;) { __syncthreads(); if (threadIdx.x == 0) tk[0] = (int)__hip_atomic_fetch_add(ctl + 240 + l, 1u, RLX_AGENT); __syncthreads();
                  const int t_ = __builtin_amdgcn_readfirstlane(tk[0]); if (t_ >= 256) break;
                  OpsPool O{(const char*)POOLED, (const char*)(ws + WS_WP + l * WP_L), 256, BW, 256};
                  pg8::OneTile S{t_ >> 2, t_ & 3};
                  pg8::EpiPool E{BR + (size_t)2 * M * BW, BW, pool_scale + (size_t)l * BW, PROJ + C_G, N1};
                  pg8::gemm_phase<pg8::EpiPool, pg8::OneTile, OpsPool, true, true>(lds, O, S, E); } }
#undef ATT_STREAM
#undef ATT_REF
#endif
        }
        CONV_FILL(pb + 4, false);
        SEAM(pb + 4);

        if (PHEN(6) && IN(pb + 5)) { PHASE_IDS KA_LOAD KA_LAYER
            const bf16* PART = (const bf16*)(ws + WS_PART); const float* ML = (const float*)(ws + WS_ML);
#pragma unroll 2
            for (int idx = bx * NTHR + tid; idx < M * 128; idx += G * NTHR) { const int row = idx >> 7, col = (idx & 127) * 8, b = row >> 13, t = row & (SEQ - 1), h = col >> 7, d = col & 127, qb = t >> 8;
                const size_t pb4 = ((size_t)((b * NH + h) * SEQ + t)) * 4; const int nsel = qb < 3 ? qb : 3;
                const f32x4 ml01 = *(const f32x4*)(ML + pb4 * 2), ml23 = *(const f32x4*)(ML + pb4 * 2 + 4);
                const float mv[4] = {ml01.x, ml01.z, ml23.x, ml23.z}, lv[4] = {ml01.y, ml01.w, ml23.y, ml23.w};
                float mx = mv[3];
#pragma unroll
                for (int q = 0; q < 3; ++q) if (q < nsel) mx = fmaxf(mx, mv[q]);
                float cf[4], den = 0.f;
#pragma unroll
                for (int q = 0; q < 4; ++q) { const bool on = (q == 3) || (q < nsel); cf[q] = on ? __builtin_amdgcn_exp2f((mv[q] - mx) * (1.4426950408889634f * 0.08838834764831845f)) * lv[q] : 0.f; den += cf[q]; }
                const float rden = 1.0f / den; float o[8] = {0.f, 0.f, 0.f, 0.f, 0.f, 0.f, 0.f, 0.f};
#pragma unroll
                for (int q = 0; q < 4; ++q) { v4u w = *(const v4u*)(PART + (pb4 + q) * 128 + d); if (!((q == 3) || (q < nsel))) w = (v4u){0u, 0u, 0u, 0u};
                    const float c_ = cf[q] * rden;
                    o[0] += c_ * pg8::bf_lo(w.x); o[1] += c_ * pg8::bf_hi(w.x); o[2] += c_ * pg8::bf_lo(w.y); o[3] += c_ * pg8::bf_hi(w.y); o[4] += c_ * pg8::bf_lo(w.z); o[5] += c_ * pg8::bf_hi(w.z); o[6] += c_ * pg8::bf_lo(w.w); o[7] += c_ * pg8::bf_hi(w.w); }
                const v4u gw_ = *(const v4u*)(PROJ + (size_t)row * N1 + A_G + col);
                const float gg[8] = {pg8::bf_lo(gw_.x), pg8::bf_hi(gw_.x), pg8::bf_lo(gw_.y), pg8::bf_hi(gw_.y), pg8::bf_lo(gw_.z), pg8::bf_hi(gw_.z), pg8::bf_lo(gw_.w), pg8::bf_hi(gw_.w)};
#pragma unroll
                for (int e = 0; e < 8; ++e) o[e] *= siluf(gg[e]);
#if DIAG_MOBA
                if (DIAG_MOBA == 1 || DIAG_MOBA == 3 || DIAG_MOBA == 4 || l == 0) { const v4u dw = *(const v4u*)(U + (size_t)row * BW + col); const float dd[8] = {pg8::bf_lo(dw.x), pg8::bf_hi(dw.x), pg8::bf_lo(dw.y), pg8::bf_hi(dw.y), pg8::bf_lo(dw.z), pg8::bf_hi(dw.z), pg8::bf_lo(dw.w), pg8::bf_hi(dw.w)};
#pragma unroll
                  for (int e = 0; e < 8; ++e) { const float df = fabsf(o[e] - dd[e]); if (df > DIAG_TOL * (fabsf(o[e]) + fabsf(dd[e])) + 2e-3f) atomicAdd((unsigned*)ctl + 200 + l, 1u); } }
#endif
                *(v4u*)(BR + (size_t)row * BW + col) = (v4u){pk2(o[0], o[1]), pk2(o[2], o[3]), pk2(o[4], o[5]), pk2(o[6], o[7])};
                { float q8[8];
#pragma unroll
                  for (int e = 0; e < 8; ++e) q8[e] = fminf(fmaxf(o[e] * BR8_SCALE, -440.0f), 440.0f);
                  unsigned w0 = 0u, w1 = 0u; w0 = __builtin_amdgcn_cvt_pk_fp8_f32(q8[0], q8[1], w0, false); w0 = __builtin_amdgcn_cvt_pk_fp8_f32(q8[2], q8[3], w0, true);
                  w1 = __builtin_amdgcn_cvt_pk_fp8_f32(q8[4], q8[5], w1, false); w1 = __builtin_amdgcn_cvt_pk_fp8_f32(q8[6], q8[7], w1, true);
                  *(unsigned long long*)(ws + WS_BR8 + (size_t)row * BW + col) = (unsigned long long)w0 | ((unsigned long long)w1 << 32); } }
        }
#if DIAG_MOBA == 4
        if (PHEN(6) && IN(pb + 5)) { PHASE_IDS KA_LOAD KA_LAYER
            for (int idx = bx * NTHR + tid; idx < M * 128; idx += G * NTHR) { const size_t o_ = (size_t)M * BW + (size_t)(idx >> 7) * BW + (idx & 127) * 8; const v4u aw = *(const v4u*)(BR + o_), dw = *(const v4u*)(U + o_);
                const float av[8] = {pg8::bf_lo(aw.x), pg8::bf_hi(aw.x), pg8::bf_lo(aw.y), pg8::bf_hi(aw.y), pg8::bf_lo(aw.z), pg8::bf_hi(aw.z), pg8::bf_lo(aw.w), pg8::bf_hi(aw.w)};
                const float dv[8] = {pg8::bf_lo(dw.x), pg8::bf_hi(dw.x), pg8::bf_lo(dw.y), pg8::bf_hi(dw.y), pg8::bf_lo(dw.z), pg8::bf_hi(dw.z), pg8::bf_lo(dw.w), pg8::bf_hi(dw.w)};
#pragma unroll
                for (int e = 0; e < 8; ++e) { const float df = fabsf(av[e] - dv[e]); if (df > DIAG_TOL * (fabsf(av[e]) + fabsf(dv[e])) + 4e-3f) atomicAdd((unsigned*)ctl + 200 + l, 1u); } } }
#endif
        SEAM(pb + 5);

        for (int rep_ = 0; rep_ < NREP(7); ++rep_) if (PHEN(7) && IN(pb + 6)) { KA_LOAD KA_LAYER
            if (STAG_US > 0) { const unsigned long long te_ = rt() + (unsigned long long)((bx & 3) * STAG_US * 100); while (rt() < te_) __builtin_amdgcn_s_sleep(8); }
            { OpsPlain O{(const char*)(ws + WS_BR8), (const char*)(ws + WS_WB + l * WB_L), BW / 2, BW / 2, BW / 2};
              pg8::StaticOrder S; S.init(M, DM, G, bx);
              pg8::EpiStoreBf16 E{U, DM, 1.0f / (BR8_SCALE * WB8_SCALE)};
              pg8::gemm_phase<pg8::EpiStoreBf16, pg8::StaticOrder, OpsPlain, true, true, 1>(lds, O, S, E); }
            { OpsUp O{(const char*)(BR + (size_t)M * BW), (const char*)(ws + WS_WB + l * WB_L + (size_t)DM * BW * 2), BW, BW, BW};
              pg8::StaticOrder S; S.init(3 * M, DM, G, bx);
              pg8::EpiStoreBf16 E{U + (size_t)M * DM, DM, 1.0f};
              pg8::gemm_phase<pg8::EpiStoreBf16, pg8::StaticOrder, OpsUp, true, true>(lds, O, S, E); }
        }
        SEAM(pb + 6);

        for (int rep_ = 0; rep_ < NREP(8); ++rep_) if (PHEN(8) && IN(pb + 7)) { KA_LOAD KA_LAYER
            if (STAG_US > 0) { const unsigned long long te_ = rt() + (unsigned long long)((bx & 3) * STAG_US * 100); while (rt() < te_) __builtin_amdgcn_s_sleep(8); }
            OpsMerge2 O{(const char*)(ws + WS_HN8), (const char*)(ws + WS_WG + l * WG_L), DM / 2, DM / 2, DM / 2};
            pg8::PairOrder S; S.base.init(M, 2 * DM, G, bx);
            pg8::EpiMerge2 E{MG, U, b_merge + (size_t)l * 4 * DM, 1.0f / (WG_SCALE * HN_SCALE), {}};
            pg8::gemm_phase<pg8::EpiMerge2, pg8::PairOrder, OpsMerge2, true, true, 1>(lds, O, S, E);
        }
        CONV_FILL(pb + 7, false);
        SEAM(pb + 7);

        for (int rep_ = 0; rep_ < (l == 0 ? NREP(9) : 1); ++rep_) if (PHEN(9) && IN(pb + 8)) { KA_LOAD KA_LAYER
            OpsPlain O{(const char*)MG, (const char*)(ws + WS_WO + l * WO_L), DM, DM, DM};
            pg8::StaticOrder S; S.init(M, DM, G, bx);
            pg8::EpiResid E{l == 0 ? x : (const float*)nullptr, (const bf16*)(ws + WS_H1), (bf16*)(ws + (l == 0 ? WS_H1 : WS_H2))};
            pg8::gemm_phase<pg8::EpiResid, pg8::StaticOrder, OpsPlain, true, true>(lds, O, S, E);
        }
        CONV_FILL(pb + 8, true);
        SEAM(pb + 8);
    }

    if (PHEN(10) && IN(PH_FINAL)) { PHASE_IDS KA_LOAD
        f32x4 gv[16];
#pragma unroll
        for (int c = 0; c < 8; ++c) { gv[2 * c] = *(const f32x4*)(final_g + 8 * (lane + 64 * c)); gv[2 * c + 1] = *(const f32x4*)(final_g + 8 * (lane + 64 * c) + 4); }
        for (int row = gw; row < M; row += NGW) {
            const bf16* hr = (const bf16*)(ws + WS_H2) + (size_t)row * DM; float* orow = out + (size_t)row * DM;
            f32x4 v[16]; float ss = 0.f;
#pragma unroll
            for (int c = 0; c < 8; ++c) { const v4u w = *(const v4u*)(hr + 8 * (lane + 64 * c)); v[2 * c] = (f32x4){pg8::bf_lo(w.x), pg8::bf_hi(w.x), pg8::bf_lo(w.y), pg8::bf_hi(w.y)}; v[2 * c + 1] = (f32x4){pg8::bf_lo(w.z), pg8::bf_hi(w.z), pg8::bf_lo(w.w), pg8::bf_hi(w.w)}; }
#pragma unroll
            for (int j = 0; j < 16; ++j) ss += (v[j].x * v[j].x + v[j].y * v[j].y) + (v[j].z * v[j].z + v[j].w * v[j].w);
            const float rstd = 1.0f / sqrtf(wave_sum(ss) * (1.0f / DM) + RMS_EPS);
#pragma unroll
            for (int c = 0; c < 8; ++c) { *(f32x4*)(orow + 8 * (lane + 64 * c)) = v[2 * c] * rstd * gv[2 * c]; *(f32x4*)(orow + 8 * (lane + 64 * c) + 4) = v[2 * c + 1] * rstd * gv[2 * c + 1]; }
#if DIAG_MOBA
            if (__hip_atomic_load((unsigned*)ctl + 200, RLX_AGENT) + __hip_atomic_load((unsigned*)ctl + 201, RLX_AGENT) > DIAG_MAXBAD) { const float qn = __builtin_nanf("");
#pragma unroll
                for (int c = 0; c < 16; ++c) *(f32x4*)(orow + 4 * (lane + 64 * c)) = (f32x4){qn, qn, qn, qn}; }
#endif
        }
    }
    if (PROBE_AVG >= 0) pacc_ = (unsigned long long)__hip_atomic_load(ctl0 + 210, RLX_AGENT) / gridDim.x;
    if (PROBE_PH >= 0 || PROBE_AVG >= 0) { if (PROBE_PH == PH_FINAL) pacc_ = rt() - pt0_; if (blockIdx.x == 0 && threadIdx.x == 0) { const unsigned long long te_ = rt() + 4ull * pacc_; while (rt() < te_) __builtin_amdgcn_s_sleep(20); } }
#undef IN
#undef SEAM
}

__global__ void __launch_bounds__(256) naive_attn(const bf16* __restrict__ proj, int qcol, int kcol, int vcol, int gcol, const float* __restrict__ cvec, const unsigned* __restrict__ sel, bf16* __restrict__ outb, int mode) {
    __shared__ float sq[HD]; __shared__ float sc[SEQ]; __shared__ float red[256];
    const int idx = blockIdx.x, t = idx & (SEQ - 1), h = (idx >> 13) & 7, b = idx >> 16, tid = threadIdx.x;
    const size_t row = (size_t)b * SEQ + t;
    if (tid < HD) sq[tid] = bf2f(proj[row * N1 + qcol + h * HD + tid]);
    __syncthreads();
    const unsigned mask = mode == 0 ? sel[(size_t)(b * NH + h) * SEQ + t] : 0xffffffffu;
    const float ct = mode == 1 ? cvec[(size_t)(b * NH + h) * SEQ + t] : 0.f;
    const float NEG = -__builtin_inff(); float lmax = NEG;
    for (int j = tid; j <= t; j += 256) { float s = NEG;
        if ((mask >> (j >> 8)) & 1u) { const v4u* kr = (const v4u*)(proj + ((size_t)b * SEQ + j) * N1 + kcol + h * HD); float a = 0.f;
#pragma unroll 4
            for (int i = 0; i < 16; ++i) { const v4u w = kr[i]; const float* q = sq + 8 * i;
                a += q[0] * pg8::bf_lo(w.x) + q[1] * pg8::bf_hi(w.x) + q[2] * pg8::bf_lo(w.y) + q[3] * pg8::bf_hi(w.y) + q[4] * pg8::bf_lo(w.z) + q[5] * pg8::bf_hi(w.z) + q[6] * pg8::bf_lo(w.w) + q[7] * pg8::bf_hi(w.w); }
            s = a * 0.08838834764831845f; if (mode == 1) s += ct - cvec[(size_t)(b * NH + h) * SEQ + j]; }
        sc[j] = s; lmax = fmaxf(lmax, s); }
    red[tid] = lmax; __syncthreads();
    for (int o = 128; o > 0; o >>= 1) { if (tid < o) red[tid] = fmaxf(red[tid], red[tid + o]); __syncthreads(); }
    const float mx = red[0]; __syncthreads();
    float lsum = 0.f;
    for (int j = tid; j <= t; j += 256) { const float p = expf(sc[j] - mx); sc[j] = p; lsum += p; }
    red[tid] = lsum; __syncthreads();
    for (int o = 128; o > 0; o >>= 1) { if (tid < o) red[tid] += red[tid + o]; __syncthreads(); }
    const float tot = red[0]; __syncthreads();
    const int d = tid & 127, half = tid >> 7; float acc = 0.f;
    const bf16* vb = proj + (size_t)b * SEQ * N1 + vcol + h * HD + d;
    for (int j = half; j <= t; j += 2) { const float p = sc[j]; if (p != 0.f) acc += p * bf2f(vb[(size_t)j * N1]); }
    red[tid] = acc; __syncthreads();
    if (tid < 128) { const float o = (red[tid] + red[tid + 128]) / tot; const float g = bf2f(proj[row * N1 + gcol + h * HD + tid]);
        outb[row * BW + h * HD + tid] = (bf16)f2bf(o * siluf(g)); }
}

extern "C" void kernel_launch(void* const* d_in, const int* in_sizes, int n_in, void* d_out, int out_size, void* d_ws, size_t ws_size, hipStream_t stream) {
    static int grid = 0;
    if (grid == 0) {
        if (n_in != 11 || in_sizes[0] != M * DM || out_size != M * DM || ws_size < WS_END) { fprintf(stderr, "kernel_launch: unexpected shapes (n_in %d, in0 %d, out %d, ws %zu < %zu); nothing launched\n", n_in, n_in > 0 ? in_sizes[0] : -1, out_size, ws_size, (size_t)WS_END); grid = -1; return; }
        int dev = 0, cus = 0, per_cu = 0;
        if (hipGetDevice(&dev) != hipSuccess || hipDeviceGetAttribute(&cus, hipDeviceAttributeMultiprocessorCount, dev) != hipSuccess) { grid = -1; return; }
        if (hipFuncSetAttribute((const void*)fwd, hipFuncAttributeMaxDynamicSharedMemorySize, LDS_BYTES) != hipSuccess) { fprintf(stderr, "kernel_launch: hipFuncSetAttribute failed\n"); grid = -1; return; }
        if (hipOccupancyMaxActiveBlocksPerMultiprocessor(&per_cu, (const void*)fwd, NTHR, LDS_BYTES) != hipSuccess || per_cu < 1) fprintf(stderr, "kernel_launch: occupancy query reports %d\n", per_cu);
        (void)hipGetLastError();
        grid = cus;
    }
    if (grid < 0) return;
    (void)hipMemsetAsync((char*)d_ws + WS_CTL, 0, CTL_ZERO_BYTES, stream);
    Args a{};
    for (int i = 0; i < 11; ++i) a.in[i] = (const float*)d_in[i];
    a.out = (float*)d_out; a.ws = (unsigned char*)d_ws;
    unsigned char* ws = (unsigned char*)d_ws;
    const bf16* PROJ = (const bf16*)(ws + WS_PROJ); bf16* BR = (bf16*)(ws + WS_BR);
#if ONE_LAUNCH && DIAG_MOBA == 2
    a.ph_lo = 0; a.ph_hi = 5; hipLaunchKernelGGL(fwd, dim3(grid), dim3(NTHR), LDS_BYTES, stream, a);
    hipLaunchKernelGGL(naive_attn, dim3(BATCH * NH * SEQ), dim3(256), 0, stream, (const bf16*)((unsigned char*)d_ws + WS_PROJ), A_Q, A_K, A_V, A_G, (const float*)nullptr, (const unsigned*)((unsigned char*)d_ws + WS_SEL), (bf16*)((unsigned char*)d_ws + WS_U), 0);
    (void)hipMemsetAsync((char*)d_ws + WS_CTL + CW_BAR * 4, 0, XCD_BAR_WORDS * 4, stream);
    a.ph_lo = 5; a.ph_hi = N_PHASES; hipLaunchKernelGGL(fwd, dim3(grid), dim3(NTHR), LDS_BYTES, stream, a);
#elif ONE_LAUNCH && (DIAG_MOBA == 3 || DIAG_MOBA == 4)
    a.ph_lo = 0; a.ph_hi = 5; hipLaunchKernelGGL(fwd, dim3(grid), dim3(NTHR), LDS_BYTES, stream, a);
    hipLaunchKernelGGL(naive_attn, dim3(BATCH * NH * SEQ), dim3(256), 0, stream, (const bf16*)((unsigned char*)d_ws + WS_PROJ), A_Q, A_K, A_V, A_G, (const float*)nullptr, (const unsigned*)((unsigned char*)d_ws + WS_SEL), (bf16*)((unsigned char*)d_ws + WS_U), 0);
    if (DIAG_MOBA == 4) hipLaunchKernelGGL(naive_attn, dim3(BATCH * NH * SEQ), dim3(256), 0, stream, (const bf16*)((unsigned char*)d_ws + WS_PROJ), B_Q, B_K, B_V, B_G, (const float*)((unsigned char*)d_ws + WS_C32), (const unsigned*)nullptr, (bf16*)((unsigned char*)d_ws + WS_U) + (size_t)M * BW, 1);
    (void)hipMemsetAsync((char*)d_ws + WS_CTL + CW_BAR * 4, 0, XCD_BAR_WORDS * 4, stream);
    a.ph_lo = 5; a.ph_hi = 14; hipLaunchKernelGGL(fwd, dim3(grid), dim3(NTHR), LDS_BYTES, stream, a);
    hipLaunchKernelGGL(naive_attn, dim3(BATCH * NH * SEQ), dim3(256), 0, stream, (const bf16*)((unsigned char*)d_ws + WS_PROJ), A_Q, A_K, A_V, A_G, (const float*)nullptr, (const unsigned*)((unsigned char*)d_ws + WS_SEL), (bf16*)((unsigned char*)d_ws + WS_U), 0);
    if (DIAG_MOBA == 4) hipLaunchKernelGGL(naive_attn, dim3(BATCH * NH * SEQ), dim3(256), 0, stream, (const bf16*)((unsigned char*)d_ws + WS_PROJ), B_Q, B_K, B_V, B_G, (const float*)((unsigned char*)d_ws + WS_C32), (const unsigned*)nullptr, (bf16*)((unsigned char*)d_ws + WS_U) + (size_t)M * BW, 1);
    (void)hipMemsetAsync((char*)d_ws + WS_CTL + CW_BAR * 4, 0, XCD_BAR_WORDS * 4, stream);
    a.ph_lo = 14; a.ph_hi = N_PHASES; hipLaunchKernelGGL(fwd, dim3(grid), dim3(NTHR), LDS_BYTES, stream, a);
#elif ONE_LAUNCH
    a.ph_lo = 0; a.ph_hi = N_PHASES;
    hipLaunchKernelGGL(fwd, dim3(grid), dim3(NTHR), LDS_BYTES, stream, a);
    (void)PROJ; (void)BR;
#else
    for (int ph = 0; ph < N_PHASES; ++ph) {
        const bool attn = !ATTN_IN_KERNEL && ph >= 1 && ph < PH_FINAL && ((ph - 1) % NPL) == 4;
        if (attn) {
            hipLaunchKernelGGL(naive_attn, dim3(BATCH * NH * SEQ), dim3(256), 0, stream, PROJ, A_Q, A_K, A_V, A_G, (const float*)nullptr, (const unsigned*)(ws + WS_SEL), BR, 0);
            hipLaunchKernelGGL(naive_attn, dim3(BATCH * NH * SEQ), dim3(256), 0, stream, PROJ, B_Q, B_K, B_V, B_G, (const float*)(ws + WS_C32), (const unsigned*)nullptr, BR + (size_t)M * BW, 1);
        } else {
            a.ph_lo = ph; a.ph_hi = ph + 1;
            hipLaunchKernelGGL(fwd, dim3(grid), dim3(NTHR), LDS_BYTES, stream, a);
        }
    }
#endif
}
```
